# Optimizing an MI355X kernel written in HIP

```python
import math
import jax, jax.numpy as jnp
from jax import lax
import numpy as np

D_MODEL = 1024
BATCH = 8
SEQ = 2048
DEPTH = 4

N_MIXERS = 3
EPS = 1e-6
D_FF = -(-8 * D_MODEL // (3 * 256)) * 256
FOURIER_GROUP = 128
N_FOURIER_GROUPS = D_MODEL // FOURIER_GROUP
S5_GROUP = 16
S5_GROUPS = D_MODEL // S5_GROUP
S5_STATE = 64
S5_DT_MIN = 1e-3
S5_DT_MAX = 1e-1
HEAD_DIM = 64
HEADS_PER_GROUP = D_MODEL // HEAD_DIM
DILATED_GROUPS = ((128, 1), (512, 4), (2048, 16))
N_ATTN_GROUPS = len(DILATED_GROUPS)
N_ATTN_HEADS = N_ATTN_GROUPS * HEADS_PER_GROUP
QKV_WIDTH = N_ATTN_GROUPS * 3 * HEADS_PER_GROUP * HEAD_DIM
ATTN_OUT = HEADS_PER_GROUP * HEAD_DIM
NUM_BUCKETS = 32
MAX_DISTANCE = 1024
N_LAYERS_A = (DEPTH + 2) // 3
N_LAYERS_B = (DEPTH + 1) // 3
N_LAYERS_C = DEPTH // 3

kernel_name = "hybrid_fnet_s5_dilated_encoder"


def rms_norm(x, g):
    xf = x.astype(jnp.float32)
    y = xf * lax.rsqrt(jnp.mean(xf * xf, axis=-1, keepdims=True) + EPS)
    return (y * g.astype(jnp.float32)).astype(x.dtype)


def swiglu(h, w_gate_up, w_down):
    gate, up = jnp.split(h @ w_gate_up, 2, axis=-1)
    return (jax.nn.silu(gate) * up) @ w_down


def fourier_mixer(h, w_out):
    b, s, d = h.shape
    hg = h.astype(jnp.float32).reshape(b, s, N_FOURIER_GROUPS, FOURIER_GROUP)
    f = jnp.fft.fft2(hg, axes=(1, 3), norm="ortho").real
    return f.reshape(b, s, d).astype(h.dtype) @ w_out


def _s5_direction(u, lam_re, lam_im, log_dt, b_re, b_im, c_re, c_im, reverse):
    f32 = jnp.float32
    lam = lax.complex(lam_re.astype(f32), lam_im.astype(f32))
    dt = jnp.exp(log_dt.astype(f32))[:, None]
    lam_bar = jnp.exp(lam * dt)
    b_bar = ((lam_bar - 1.0) / lam)[..., None] * lax.complex(b_re.astype(f32), b_im.astype(f32))
    bu = lax.complex(jnp.einsum('bsgp,gnp->bsgn', u, b_bar.real),
                     jnp.einsum('bsgp,gnp->bsgn', u, b_bar.imag))
    a = jnp.broadcast_to(lam_bar, bu.shape)

    def combine(e1, e2):
        a1, x1 = e1
        a2, x2 = e2
        return a1 * a2, a2 * x1 + x2

    _, hs = lax.associative_scan(combine, (a, bu), axis=1, reverse=reverse)
    c = lax.complex(c_re.astype(f32), c_im.astype(f32))
    return jnp.einsum('gpn,bsgn->bsgp', c, hs).real


def s5_mixer(h, lam_re, lam_im, log_dt, b_re, b_im, c_re, c_im, d_skip, w_glu):
    b, s, d = h.shape
    hf = h.astype(jnp.float32)
    u = hf.reshape(b, s, S5_GROUPS, S5_GROUP)
    y_fwd = _s5_direction(u, lam_re[0], lam_im[0], log_dt[0], b_re[0], b_im[0], c_re[0], c_im[0], False)
    y_bwd = _s5_direction(u, lam_re[1], lam_im[1], log_dt[1], b_re[1], b_im[1], c_re[1], c_im[1], True)
    y = (y_fwd + y_bwd).reshape(b, s, d) + d_skip.astype(jnp.float32) * hf
    g = jax.nn.gelu(y).astype(h.dtype)
    val, gate = jnp.split(g @ w_glu, 2, axis=-1)
    return val * jax.nn.sigmoid(gate)


def t5_bucket(rel):
    half = NUM_BUCKETS // 2
    max_exact = half // 2
    n = np.abs(rel)
    sign = (rel > 0).astype(np.int32) * half
    large = max_exact + (np.log(np.maximum(n, 1) / max_exact) / math.log(MAX_DISTANCE / max_exact)
                         * (half - max_exact)).astype(np.int32)
    large = np.minimum(large, half - 1)
    return (sign + np.where(n < max_exact, n, large)).astype(np.int32)


def head_rms_norm(t, g):
    tf = t.astype(jnp.float32)
    y = tf * lax.rsqrt(jnp.mean(tf * tf, axis=-1, keepdims=True) + EPS)
    return (y * g.astype(jnp.float32)).astype(t.dtype)


def dilated_group_attention(q, k, v, bias_g, dil, n_side):
    bsz, s, nh, e = q.shape
    seg = s // dil
    blk = n_side
    nb = -(-seg // blk)
    segp = nb * blk

    def res(t):
        return t.reshape(bsz, seg, dil, nh, e).transpose(0, 2, 1, 3, 4)

    qb = jnp.pad(res(q), ((0, 0), (0, 0), (0, segp - seg), (0, 0), (0, 0))).reshape(bsz, dil, nb, blk, nh, e)

    def kv_blocks(t):
        tp = jnp.pad(res(t), ((0, 0), (0, 0), (blk, segp - seg + blk), (0, 0), (0, 0)))
        tp = tp.reshape(bsz, dil, nb + 2, blk, nh, e)
        return jnp.concatenate([tp[:, :, :-2], tp[:, :, 1:-1], tp[:, :, 2:]], axis=3)

    kb = kv_blocks(k)
    vb = kv_blocks(v)
    qi = np.arange(blk)[:, None]
    ki = np.arange(3 * blk)[None, :]
    off = ki - blk - qi
    band = np.abs(off) <= n_side
    key_idx = np.arange(nb)[:, None] * blk + np.arange(3 * blk)[None, :] - blk
    in_range = (key_idx >= 0) & (key_idx < seg)
    allowed = band[None] & in_range[:, None, :]
    buckets = t5_bucket(off * dil)
    bias = jnp.transpose(bias_g.astype(jnp.float32)[buckets], (2, 0, 1))

    sc = jnp.einsum('brnqhe,brnkhe->brnhqk', qb, kb, preferred_element_type=jnp.float32) * (e ** -0.5)
    sc = jnp.where(allowed[None, None, :, None], sc + bias, -1e30)
    m = jnp.max(sc, axis=-1, keepdims=True)
    p = jnp.exp(sc - m)
    den = jnp.sum(p, axis=-1, keepdims=True)
    o = jnp.einsum('brnhqk,brnkhe->brnqhe', (p / den).astype(v.dtype), vb)
    lse = (m + jnp.log(den))[..., 0]
    o = o.reshape(bsz, dil, segp, nh, e)[:, :, :seg].transpose(0, 2, 1, 3, 4).reshape(bsz, s, nh, e)
    lse = lse.transpose(0, 1, 2, 4, 3).reshape(bsz, dil, segp, nh)[:, :, :seg]
    lse = lse.transpose(0, 2, 1, 3).reshape(bsz, s, nh)
    return o, lse


def dilated_attention_mixer(h, w_qkv, q_gain, k_gain, w_o, rel_bias):
    b, s, d = h.shape
    qkv = (h @ w_qkv).reshape(b, s, N_ATTN_GROUPS, 3, HEADS_PER_GROUP, HEAD_DIM)
    outs = []
    lses = []
    for g, (window, dil) in enumerate(DILATED_GROUPS):
        q = head_rms_norm(qkv[:, :, g, 0], q_gain[g])
        k = head_rms_norm(qkv[:, :, g, 1], k_gain[g])
        v = qkv[:, :, g, 2]
        bias_g = rel_bias[:, g * HEADS_PER_GROUP:(g + 1) * HEADS_PER_GROUP]
        o, l = dilated_group_attention(q, k, v, bias_g, dil, (window // 2) // dil)
        outs.append(o)
        lses.append(l)
    wts = jax.nn.softmax(jnp.stack(lses, axis=0), axis=0)
    o = jnp.einsum('gbsh,gbshe->bshe', wts, jnp.stack(outs, axis=0).astype(jnp.float32))
    return o.reshape(b, s, ATTN_OUT).astype(h.dtype) @ w_o


def setup_inputs(seed: int = 0) -> dict:
    key = jax.random.key(seed)
    ks = jax.random.split(key, 24)
    f32 = jnp.float32
    d = D_MODEL

    def nrm(k, shape, scale):
        return jax.random.normal(k, shape, f32) * scale

    s5_shape = (N_LAYERS_B, 2, S5_GROUPS, S5_STATE)
    n_idx = jnp.arange(S5_STATE, dtype=f32)
    return {
        "x": nrm(ks[0], (BATCH, SEQ, d), 1.0),
        "norm_mix_g": 1.0 + nrm(ks[1], (DEPTH, d), 0.1),
        "norm_ffn_g": 1.0 + nrm(ks[2], (DEPTH, d), 0.1),
        "fnet_w_out": nrm(ks[3], (N_LAYERS_A, d, d), d ** -0.5),
        "s5_lambda_re": -0.5 + nrm(ks[4], s5_shape, 0.01),
        "s5_lambda_im": math.pi * n_idx + nrm(ks[5], s5_shape, 0.01),
        "s5_log_dt": jax.random.uniform(ks[6], (N_LAYERS_B, 2, S5_GROUPS), f32,
                                        math.log(S5_DT_MIN), math.log(S5_DT_MAX)),
        "s5_b_re": nrm(ks[7], (N_LAYERS_B, 2, S5_GROUPS, S5_STATE, S5_GROUP), (2 * S5_GROUP) ** -0.5),
        "s5_b_im": nrm(ks[8], (N_LAYERS_B, 2, S5_GROUPS, S5_STATE, S5_GROUP), (2 * S5_GROUP) ** -0.5),
        "s5_c_re": nrm(ks[9], (N_LAYERS_B, 2, S5_GROUPS, S5_GROUP, S5_STATE), S5_STATE ** -0.5),
        "s5_c_im": nrm(ks[10], (N_LAYERS_B, 2, S5_GROUPS, S5_GROUP, S5_STATE), S5_STATE ** -0.5),
        "s5_d": nrm(ks[11], (N_LAYERS_B, d), 1.0),
        "s5_w_glu": nrm(ks[12], (N_LAYERS_B, d, 2 * d), d ** -0.5),
        "attn_w_qkv": nrm(ks[13], (N_LAYERS_C, d, QKV_WIDTH), d ** -0.5),
        "attn_q_gain": 1.0 + nrm(ks[14], (N_LAYERS_C, N_ATTN_GROUPS, HEAD_DIM), 0.1),
        "attn_k_gain": 1.0 + nrm(ks[15], (N_LAYERS_C, N_ATTN_GROUPS, HEAD_DIM), 0.1),
        "attn_w_o": nrm(ks[16], (N_LAYERS_C, ATTN_OUT, d), ATTN_OUT ** -0.5),
        "rel_bias": nrm(ks[17], (NUM_BUCKETS, N_ATTN_HEADS), 0.5),
        "ffn_w_gate_up": nrm(ks[18], (DEPTH, d, 2 * D_FF), d ** -0.5),
        "ffn_w_down": nrm(ks[19], (DEPTH, D_FF, d), D_FF ** -0.5),
    }


def reference(x, norm_mix_g, norm_ffn_g, fnet_w_out, s5_lambda_re, s5_lambda_im, s5_log_dt,
              s5_b_re, s5_b_im, s5_c_re, s5_c_im, s5_d, s5_w_glu, attn_w_qkv, attn_q_gain,
              attn_k_gain, attn_w_o, rel_bias, ffn_w_gate_up, ffn_w_down):
    counts = [0, 0, 0]
    for i in range(DEPTH):
        kind = i % N_MIXERS
        j = counts[kind]
        counts[kind] += 1
        h = rms_norm(x, norm_mix_g[i])
        if kind == 0:
            mix = fourier_mixer(h, fnet_w_out[j])
        elif kind == 1:
            mix = s5_mixer(h, s5_lambda_re[j], s5_lambda_im[j], s5_log_dt[j], s5_b_re[j], s5_b_im[j],
                           s5_c_re[j], s5_c_im[j], s5_d[j], s5_w_glu[j])
        else:
            mix = dilated_attention_mixer(h, attn_w_qkv[j], attn_q_gain[j], attn_k_gain[j],
                                          attn_w_o[j], rel_bias)
        x = x + mix.astype(x.dtype)
        h = rms_norm(x, norm_ffn_g[i])
        x = x + swiglu(h, ffn_w_gate_up[i], ffn_w_down[i]).astype(x.dtype)
    return x
```

```cpp
#include <hip/hip_runtime.h>
#include <cstdio>
#include <cstdint>

#define LAS __attribute__((address_space(3)))
#define GAS __attribute__((address_space(1)))
typedef unsigned short bf16_t;
typedef short bf16x8 __attribute__((ext_vector_type(8)));
typedef float f32x4 __attribute__((ext_vector_type(4)));
typedef float f32x2 __attribute__((ext_vector_type(2)));
typedef float f32x16 __attribute__((ext_vector_type(16)));
typedef unsigned u32x4 __attribute__((ext_vector_type(4)));
typedef unsigned u32x2 __attribute__((ext_vector_type(2)));
typedef GAS unsigned gu32;

constexpr int BATCH = 8, SEQ = 2048, DM = 1024, MTOK = BATCH * SEQ, DFF = 2816, DEPTH = 4;
constexpr float EPS = 1e-6f;
constexpr float LOG2E = 1.4426950408889634f;

__device__ __forceinline__ unsigned f2bf(float f) { unsigned u = __builtin_bit_cast(unsigned, f); return (u + 0x7fffu + ((u >> 16) & 1u)) >> 16; }
typedef __bf16 bf16x2_t __attribute__((ext_vector_type(2)));
__device__ __forceinline__ unsigned pk2(float lo, float hi) { const f32x2 v = {lo, hi}; return __builtin_bit_cast(unsigned, __builtin_convertvector(v, bf16x2_t)); }
__device__ __forceinline__ float bf2f(unsigned short h) { return __builtin_bit_cast(float, (unsigned)h << 16); }
__device__ __forceinline__ float bflo(unsigned w) { return __builtin_bit_cast(float, w << 16); }
__device__ __forceinline__ float bfhi(unsigned w) { return __builtin_bit_cast(float, w & 0xffff0000u); }
__device__ __forceinline__ float fast_rcp(float x) { return __builtin_amdgcn_rcpf(x); }
__device__ __forceinline__ float fast_exp2(float x) { return __builtin_amdgcn_exp2f(x); }
__device__ __forceinline__ float sigmoidf_(float x) { return fast_rcp(1.0f + fast_exp2(-LOG2E * x)); }
__device__ __forceinline__ float rstd_of(float ss) { return __builtin_amdgcn_rsqf(ss * (1.0f / DM) + EPS); }
template <int NS4> __device__ __forceinline__ float rstd_tok_u(const float* ssp, int tok) {
    const f32x4* p = (const f32x4*)(ssp + (size_t)tok * 32); f32x4 v[NS4];
#pragma unroll
    for (int i = 0; i < NS4; ++i) v[i] = p[i];
    float s = 0.f;
#pragma unroll
    for (int i = 0; i < NS4; ++i) s += (v[i][0] + v[i][1]) + (v[i][2] + v[i][3]);
    return rstd_of(s);
}
template <int NS4> __device__ __forceinline__ float rstd_tok_u64(const float* ssp, int tok) {
    const f32x4* p = (const f32x4*)(ssp + (size_t)tok * 64); f32x4 v[NS4];
#pragma unroll
    for (int i = 0; i < NS4; ++i) v[i] = p[i];
    float s = 0.f;
#pragma unroll
    for (int i = 0; i < NS4; ++i) s += (v[i][0] + v[i][1]) + (v[i][2] + v[i][3]);
    return rstd_of(s);
}
__device__ __forceinline__ float rstd_tok(const float* ssp, int tok, int ns4) { return ns4 == 16 ? rstd_tok_u64<16>(ssp, tok) : (ns4 == 8 ? rstd_tok_u<8>(ssp, tok) : rstd_tok_u<4>(ssp, tok)); }

namespace pg8 {
constexpr int BM = 256, BK = 64, HALF = 128, HTB = HALF * BK * 2  , STAGE_BYTES = 8 * HTB, NXCD = 8, WGM = 8;
__host__ __device__ __forceinline__ int lds_byte(int r, int c) { const int st = (r >> 4) * 2 + (c >> 5), rr = r & 15, cc = c & 31, ob = rr * 64 + cc * 2; return st * 1024 + (ob ^ (((ob >> 9) & 1) << 5)); }
__host__ __device__ __forceinline__ void stage_rc(int b, int& R, int& C) { const int st = b / 1024, sb = b % 1024, swz = sb ^ (((sb >> 9) & 1) << 5); R = (st >> 1) * 16 + swz / 64; C = (st & 1) * 32 + (swz % 64) / 2; }

struct Unit { int pm, pn; };
struct Geo {
    const char* A; const char* B; int K, nM, nN;
    unsigned rsA, rsB, hsA, hsB;
    size_t tsA, tsB;
    int modeA, modeB;
    int bsel;
    unsigned kwA;
    int dil;
    __device__ __forceinline__ size_t gather(int p) const {
        const int b = p >> 3, vin0 = (p & 7) * 256;
        const int tok0 = dil == 1 ? vin0 : (dil == 4 ? ((vin0 & 511) * 4 + (vin0 >> 9)) : (vin0 >> 7));
        return (size_t)(b * 2048 + tok0) * 2048u;
    }
    __device__ __forceinline__ size_t offA(const Unit& u) const { return (size_t)kwA * (unsigned)u.pn + (modeA == 2 ? (size_t)((u.pm >> 3) * 2048 + (u.pm & 7) * 8) * 2048u : (modeA ? gather(u.pm) : (size_t)u.pm * tsA)); }
    __device__ __forceinline__ size_t offB(const Unit& u) const { const int i = bsel ? (u.pm >> 2) : u.pn; return modeB ? gather(i) : (size_t)i * tsB; }
};
struct StaticOrder {
    int nM, nN, nwg, G, c;
    __device__ void init(int nM_, int nN_, int G_, int c_) { nM = nM_; nN = nN_; nwg = nM * nN; G = G_; c = c_; }
    __device__ bool next(int i, Unit& u) const {
        const long L = (long)i * G + c; if (L >= nwg) return false;
        int wgid = (int)L; { const int q = nwg / NXCD, r = nwg % NXCD, xcd = wgid % NXCD, off = wgid / NXCD; wgid = (xcd < r ? xcd * (q + 1) : r * (q + 1) + (xcd - r) * q) + off; }
        const int nig = WGM * nN, gid = wgid / nig, fm = gid * WGM, gsz = (nM - fm) < WGM ? (nM - fm) : WGM;
        u.pm = fm + ((wgid % nig) % gsz); u.pn = (wgid % nig) / gsz; return true;
    }
};

template <class Epi>
__device__ __forceinline__ void gemm_phase(LAS unsigned char* lds, const Geo g, const StaticOrder& S, const Epi& E) {
    int tid_ = threadIdx.x; asm volatile("" : "+v"(tid_));
    const int tid = tid_, wid = __builtin_amdgcn_readfirstlane(tid >> 6), lane = tid & 63, wr = wid >> 2, wc = wid & 3, fr = lane & 15, fq = lane >> 4;
    const int K = g.K, nt = K / BK;
    unsigned voffA[2], voffB[2];
#pragma unroll
    for (int i = 0; i < 2; ++i) { int R, C; stage_rc(tid * 16 + i * 8192, R, C); voffA[i] = (g.modeA == 2 ? (unsigned)((R & 31) * 64 + (R >> 5)) * 2048u : (unsigned)R * g.rsA) + (unsigned)C * 2u; voffB[i] = (unsigned)R * g.rsB + (unsigned)C * 2u; }
    const size_t kstep = (size_t)(BK * 2);
    const size_t hstepA = g.hsA, hstepB = g.hsB;
    const unsigned ldsw = (unsigned)wid * 1024u;
    const int aoff = lds_byte(wr * 64 + fr, fq * 8), boff = lds_byte(wc * 32 + fr, fq * 8);
#define PG8_SA(b, h) (((b) * 2 + (h)) * HTB)
#define PG8_SB(b, h) ((4 + (b) * 2 + (h)) * HTB)
#define PG8_STAGE(bufoff, gbase, voff) do { _Pragma("unroll") for (int _i = 0; _i < 2; ++_i) \
        __builtin_amdgcn_global_load_lds((const unsigned*)((const char*)(gbase) + (voff)[_i]), (LAS unsigned*)(lds + (bufoff) + ldsw + _i * 8192), 16, 0, 0); } while (0)
#define PG8_LDA(dst, b, h) do { _Pragma("unroll") for (int m = 0; m < 4; ++m) _Pragma("unroll") for (int k = 0; k < 2; ++k) dst[m][k] = *(const LAS bf16x8*)(lds + PG8_SA(b, h) + aoff + m * 2048 + k * 1024); } while (0)
#define PG8_LDB(dst, b, h) do { _Pragma("unroll") for (int n = 0; n < 2; ++n) _Pragma("unroll") for (int k = 0; k < 2; ++k) dst[n][k] = *(const LAS bf16x8*)(lds + PG8_SB(b, h) + boff + n * 2048 + k * 1024); } while (0)
#define PG8_MMA(ai, bj, At, Bt) do { __builtin_amdgcn_s_setprio(1); _Pragma("unroll") for (int m = 0; m < 4; ++m) _Pragma("unroll") for (int n = 0; n < 2; ++n) _Pragma("unroll") for (int k = 0; k < 2; ++k) \
        acc[ai][bj][m][n] = __builtin_amdgcn_mfma_f32_16x16x32_bf16(Bt[n][k], At[m][k], acc[ai][bj][m][n], 0, 0, 0); __builtin_amdgcn_s_setprio(0); } while (0)
#define PG8_WAIT_V(n) asm volatile("s_waitcnt vmcnt(" #n ")" ::: "memory")
#define PG8_WAIT_L(n) asm volatile("s_waitcnt lgkmcnt(" #n ")" ::: "memory")
#define PG8_BAR __builtin_amdgcn_s_barrier()
#define PG8_SCHED __builtin_amdgcn_sched_barrier(0)
    Unit cur, nxt; int ui = 0;
    if (!S.next(0, cur)) return;
    f32x4 acc[2][2][4][2];
#pragma unroll
    for (int a = 0; a < 2; ++a)
#pragma unroll
        for (int b = 0; b < 2; ++b)
#pragma unroll
            for (int m = 0; m < 4; ++m)
#pragma unroll
                for (int n = 0; n < 2; ++n) acc[a][b][m][n] = (f32x4){0.f, 0.f, 0.f, 0.f};
    bf16x8 At[4][2], B0[2][2], B1[2][2];
    const char* cA = g.A + g.offA(cur); const char* cB = g.B + g.offB(cur);
    PG8_STAGE(PG8_SB(0, 0), cB, voffB); PG8_STAGE(PG8_SB(0, 1), cB + hstepB, voffB); PG8_STAGE(PG8_SA(0, 0), cA, voffA); PG8_STAGE(PG8_SA(0, 1), cA + hstepA, voffA);
    E.pre(S);
    if (wr == 1) PG8_BAR;
    PG8_WAIT_V(2); PG8_BAR;
    PG8_STAGE(PG8_SB(1, 0), cB + kstep, voffB); PG8_STAGE(PG8_SA(1, 0), cA + kstep, voffA); PG8_STAGE(PG8_SB(1, 1), cB + hstepB + kstep, voffB);
    PG8_WAIT_V(6); PG8_BAR;
    for (;;) {
        const bool has_next = S.next(ui + 1, nxt);
        const char* nA = has_next ? g.A + g.offA(nxt) : cA; const char* nB = has_next ? g.B + g.offB(nxt) : cB;
        for (int t = 0; t < nt; t += 2) {
            const bool last = (t == nt - 2);
            const char* a1 = cA + (size_t)(t + 1) * kstep;
            const char* a2 = last ? nA : cA + (size_t)(t + 2) * kstep; const char* b2 = last ? nB : cB + (size_t)(t + 2) * kstep;
            const char* a3 = a2 + kstep; const char* b3 = b2 + kstep;
            PG8_LDB(B0, 0, 0); PG8_LDB(B1, 0, 1); PG8_SCHED; PG8_LDA(At, 0, 0); PG8_STAGE(PG8_SA(1, 1), a1 + hstepA, voffA);
            PG8_WAIT_V(8); PG8_WAIT_L(0); PG8_BAR; PG8_MMA(0, 0, At, B0); PG8_MMA(0, 1, At, B1); PG8_BAR; PG8_SCHED;
            PG8_LDA(At, 0, 1); PG8_STAGE(PG8_SB(0, 0), b2, voffB); PG8_STAGE(PG8_SB(0, 1), b2 + hstepB, voffB); PG8_STAGE(PG8_SA(0, 0), a2, voffA);
            PG8_WAIT_V(8); PG8_WAIT_L(0); PG8_BAR; PG8_MMA(1, 0, At, B0); PG8_MMA(1, 1, At, B1); PG8_BAR; PG8_SCHED;
            PG8_LDB(B0, 1, 0); PG8_LDB(B1, 1, 1); PG8_SCHED; PG8_LDA(At, 1, 0); PG8_STAGE(PG8_SA(0, 1), a2 + hstepA, voffA);
            PG8_WAIT_V(8); PG8_WAIT_L(0); PG8_BAR; PG8_MMA(0, 0, At, B0); PG8_MMA(0, 1, At, B1); PG8_BAR; PG8_SCHED;
            PG8_LDA(At, 1, 1); PG8_STAGE(PG8_SB(1, 0), b3, voffB); PG8_STAGE(PG8_SB(1, 1), b3 + hstepB, voffB); PG8_STAGE(PG8_SA(1, 0), a3, voffA);
            PG8_WAIT_V(8); PG8_WAIT_L(0); PG8_BAR; PG8_MMA(1, 0, At, B0); PG8_MMA(1, 1, At, B1); PG8_BAR; PG8_SCHED;
        }
        if (wr == 0) PG8_BAR;
        E(acc, cur, ui, wr, wc, fr, fq);
        if (!has_next) break;
#pragma unroll
        for (int a = 0; a < 2; ++a)
#pragma unroll
            for (int b = 0; b < 2; ++b)
#pragma unroll
                for (int m = 0; m < 4; ++m)
#pragma unroll
                    for (int n = 0; n < 2; ++n) acc[a][b][m][n] = (f32x4){0.f, 0.f, 0.f, 0.f};
        cur = nxt; cA = nA; cB = nB; ++ui;
        if (wr == 1) PG8_BAR;
    }
    PG8_WAIT_V(0);
    PG8_BAR;
#undef PG8_SA
#undef PG8_SB
#undef PG8_STAGE
#undef PG8_LDA
#undef PG8_LDB
#undef PG8_MMA
#undef PG8_WAIT_V
#undef PG8_WAIT_L
#undef PG8_BAR
#undef PG8_SCHED
}
}
namespace epi {
using pg8::Unit;
typedef const f32x4 (&AccRef)[2][2][4][2];

__device__ __forceinline__ int tokmap(int vin, int dil) {
    return dil == 1 ? vin : (dil == 4 ? ((vin & 511) * 4 + (vin >> 9)) : ((vin & 127) * 16 + (vin >> 7)));
}

struct ColScale {
    bf16_t* out; const float* ss; int ns4, mode, dil; LAS float* rl;
    __device__ __forceinline__ void operator()(AccRef acc, const Unit& u, int ui, int wr, int wc, int fr_, int fq_) const {
        int fr = fr_, fq = fq_; asm volatile("" : "+v"(fr), "+v"(fq));
        const int b = u.pn >> 3, cin0 = (u.pn & 7) * 256;
        f32x4 sc[2][2];
#pragma unroll
        for (int bj = 0; bj < 2; ++bj)
#pragma unroll
            for (int n = 0; n < 2; ++n) sc[bj][n] = *(const LAS f32x4*)(rl + ui * 256 + bj * 128 + wc * 32 + n * 16 + 4 * fq);
#pragma unroll
        for (int ai = 0; ai < 2; ++ai)
#pragma unroll
            for (int m = 0; m < 4; ++m) {
                const int row = u.pm * 256 + ai * 128 + wr * 64 + m * 16 + fr;
                bf16_t* rp;
                if (mode == 0) rp = out + ((size_t)(b * 1024 + (row & 1023)) * 4096 + (row >> 10) * 2048);
                else rp = out + (size_t)(b * 1024 + row) * 2048;
#pragma unroll
                for (int bj = 0; bj < 2; ++bj)
#pragma unroll
                    for (int n = 0; n < 2; ++n) {
                        const int cb = cin0 + wc * 32 + bj * 128 + n * 16;
                        const int c = mode == 0 ? cb + 4 * fq : cb + 8 * (fq & 1) + 4 * (fq >> 1);
                        const f32x4 v = acc[ai][bj][m][n] * sc[bj][n];
                        u32x2 w; w.x = pk2(v[0], v[1]); w.y = pk2(v[2], v[3]);
                        *(u32x2*)(rp + c) = w;
                    }
            }
    }
};

struct FnetStore {
    bf16_t* gt; const float* ss; int ns4; LAS float* rl;
    __device__ __forceinline__ void operator()(AccRef acc, const Unit& u, int ui, int wr, int wc, int fr_, int fq_) const {
        int fr = fr_, fq = fq_; asm volatile("" : "+v"(fr), "+v"(fq));
        const int b = u.pm >> 3, tb = (u.pm & 7) * 8;
#pragma unroll
        for (int ai = 0; ai < 2; ++ai)
#pragma unroll
            for (int m = 0; m < 4; ++m) {
                const int rl_ = ai * 128 + wr * 64 + m * 16 + fr, s2 = tb + (rl_ >> 5), cell = (rl_ & 31) ^ ((s2 & 1) << 2); const float r = rl[ui * 256 + rl_];
#pragma unroll
                for (int bj = 0; bj < 2; ++bj)
#pragma unroll
                    for (int n = 0; n < 2; ++n) {
                        const int nblk = 8 * u.pn + 4 * bj + wc;
                        const f32x4 v = acc[ai][bj][m][n] * r; u32x2 w; w.x = pk2(v[0], v[1]); w.y = pk2(v[2], v[3]);
                        *(u32x2*)(gt + ((((size_t)(b * 64 + nblk) * 2 + n) * 64 + s2) * 32 + cell) * 16 + 4 * fq) = w;
                    }
            }
    }
};

struct Resid {
    float* xout; bf16_t* xb; float* ssn; int glu;
    __device__ __forceinline__ void operator()(AccRef acc, const Unit& u, int ui, int wr, int wc, int fr_, int fq_) const {
        int fr = fr_, fq = fq_; asm volatile("" : "+v"(fr), "+v"(fq));
        const int row0 = u.pm * 256 + wr * 64 + fr;
#pragma unroll
        for (int ai = 0; ai < 2; ++ai) {
            u32x4 bs[4][2];
#pragma unroll
            for (int m = 0; m < 4; ++m) { const size_t ro = (size_t)(row0 + ai * 128 + m * 16) * DM;
                if (glu) { bs[m][0] = *(const u32x4*)(xb + ro + 128 * u.pn + 32 * wc + 8 * fq); bs[m][1] = (u32x4){0u, 0u, 0u, 0u}; }
                else {
#pragma unroll
                    for (int bj = 0; bj < 2; ++bj) bs[m][bj] = *(const u32x4*)(xb + ro + u.pn * 256 + bj * 128 + wc * 32 + 8 * fq); } }
            asm volatile("" ::: "memory");
#pragma unroll
            for (int m = 0; m < 4; ++m) {
                const int tok = row0 + ai * 128 + m * 16; const size_t ro = (size_t)tok * DM; float s2 = 0.f;
                if (glu) {
                    const int j = 128 * u.pn + 32 * wc + 8 * fq; const u32x4 b4 = bs[m][0]; float o[8];
                    const float bv[8] = {bflo(b4.x), bfhi(b4.x), bflo(b4.y), bfhi(b4.y), bflo(b4.z), bfhi(b4.z), bflo(b4.w), bfhi(b4.w)};
#pragma unroll
                    for (int bj = 0; bj < 2; ++bj)
#pragma unroll
                        for (int e = 0; e < 4; ++e) { const float v = bv[4 * bj + e] + acc[ai][bj][m][0][e] * sigmoidf_(acc[ai][bj][m][1][e]); o[4 * bj + e] = v; s2 += v * v; }
                    if (xout) { *(f32x4*)(xout + ro + j) = (f32x4){o[0], o[1], o[2], o[3]}; *(f32x4*)(xout + ro + j + 4) = (f32x4){o[4], o[5], o[6], o[7]}; }
                    else { u32x4 w; w.x = pk2(o[0], o[1]); w.y = pk2(o[2], o[3]); w.z = pk2(o[4], o[5]); w.w = pk2(o[6], o[7]); *(u32x4*)(xb + ro + j) = w; }
                } else {
#pragma unroll
                    for (int bj = 0; bj < 2; ++bj) {
                        const int c = u.pn * 256 + bj * 128 + wc * 32 + 8 * fq; const u32x4 b4 = bs[m][bj];
                        const f32x4 o0 = (f32x4){bflo(b4.x), bfhi(b4.x), bflo(b4.y), bfhi(b4.y)} + acc[ai][bj][m][0], o1 = (f32x4){bflo(b4.z), bfhi(b4.z), bflo(b4.w), bfhi(b4.w)} + acc[ai][bj][m][1];
                        s2 += ((o0[0] * o0[0] + o0[1] * o0[1]) + (o0[2] * o0[2] + o0[3] * o0[3])) + ((o1[0] * o1[0] + o1[1] * o1[1]) + (o1[2] * o1[2] + o1[3] * o1[3]));
                        if (xout) { __builtin_nontemporal_store(o0, (f32x4*)(xout + ro + c)); __builtin_nontemporal_store(o1, (f32x4*)(xout + ro + c + 4)); }
                        else { u32x4 w; w.x = pk2(o0[0], o0[1]); w.y = pk2(o0[2], o0[3]); w.z = pk2(o1[0], o1[1]); w.w = pk2(o1[2], o1[3]); *(u32x4*)(xb + ro + c) = w; }
                    }
                }
                s2 += __shfl_xor(s2, 16); s2 += __shfl_xor(s2, 32);
                if (fq == 0 && ssn) ssn[(size_t)tok * 32 + u.pn * 4 + wc] = s2;
            }
        }
    }
};

struct SwiGlu {
    bf16_t* hd; const float* ss; int ns4; LAS float* rl;
    __device__ __forceinline__ void operator()(AccRef acc, const Unit& u, int ui, int wr, int wc, int fr_, int fq_) const {
        int fr = fr_, fq = fq_; asm volatile("" : "+v"(fr), "+v"(fq));
#pragma unroll
        for (int ai = 0; ai < 2; ++ai)
#pragma unroll
            for (int m = 0; m < 4; ++m) {
                const int rl_ = ai * 128 + wr * 64 + m * 16 + fr, tok = u.pm * 256 + rl_; const float r = rl[ui * 256 + rl_]; float h[8];
#pragma unroll
                for (int bj = 0; bj < 2; ++bj) {
                    const f32x4 ga = acc[ai][bj][m][0], ua = acc[ai][bj][m][1];
#pragma unroll
                    for (int e = 0; e < 4; ++e) { const float gg = r * ga[e]; h[4 * bj + e] = gg * sigmoidf_(gg) * (r * ua[e]); }
                }
                u32x4 w; w.x = pk2(h[0], h[1]); w.y = pk2(h[2], h[3]); w.z = pk2(h[4], h[5]); w.w = pk2(h[6], h[7]);
                *(u32x4*)(hd + (size_t)tok * DFF + 128 * u.pn + 32 * wc + 8 * fq) = w;
            }
    }
};

struct QkNorm {
    bf16_t* qc; bf16_t* kc; bf16_t* vc; const float* ss; int ns4; const float* qgain; const float* kgain; int dil; float qscale; LAS float* rl;
    __device__ __forceinline__ void operator()(AccRef acc, const Unit& u, int ui, int wr, int wc, int fr_, int fq_) const {
        int fr = fr_, fq = fq_; asm volatile("" : "+v"(fr), "+v"(fq));
        const int which = u.pn >> 2, hh = 4 * (u.pn & 3) + wc;
        if (which == 2) {
#pragma unroll
            for (int ai = 0; ai < 2; ++ai)
#pragma unroll
                for (int m = 0; m < 4; ++m) { const int rl_ = ai * 128 + wr * 64 + m * 16 + fr; const float r = rl[ui * 256 + rl_];
#pragma unroll
                    for (int bj = 0; bj < 2; ++bj) { const f32x4 a0 = acc[ai][bj][m][0] * r, a1 = acc[ai][bj][m][1] * r;
                        u32x4 w; w.x = pk2(a0[0], a0[1]); w.y = pk2(a0[2], a0[3]); w.z = pk2(a1[0], a1[1]); w.w = pk2(a1[2], a1[3]);
                        *(u32x4*)(vc + (size_t)(u.pm * 256 + rl_) * DM + hh * 64 + 32 * bj + 8 * fq) = w; } }
            return;
        }
        const float* gp = which ? kgain : qgain; const float osc = which ? 1.0f : qscale;
        bf16_t* ob = (which ? kc : qc) + hh * 64;
        f32x4 gn[2][2];
#pragma unroll
        for (int bj = 0; bj < 2; ++bj)
#pragma unroll
            for (int n = 0; n < 2; ++n) gn[bj][n] = *(const f32x4*)(gp + 32 * bj + 16 * n + 4 * fq) * osc;
        const int b = u.pm >> 3;
#pragma unroll
        for (int ai = 0; ai < 2; ++ai)
#pragma unroll
            for (int m = 0; m < 4; ++m) {
                const int rl_ = ai * 128 + wr * 64 + m * 16 + fr; const int v = u.pm * 256 + rl_;
                const float r = rl[ui * 256 + rl_]; float s2 = 0.f;
#pragma unroll
                for (int bj = 0; bj < 2; ++bj)
#pragma unroll
                    for (int n = 0; n < 2; ++n) { const f32x4 a = acc[ai][bj][m][n]; s2 += (a[0] * a[0] + a[1] * a[1]) + (a[2] * a[2] + a[3] * a[3]); }
                s2 += __shfl_xor(s2, 16); s2 += __shfl_xor(s2, 32);
                const float f = r * __builtin_amdgcn_rsqf(r * r * s2 * (1.0f / 64.0f) + EPS);
#pragma unroll
                for (int bj = 0; bj < 2; ++bj) { const f32x4 a0 = acc[ai][bj][m][0] * f * gn[bj][0], a1 = acc[ai][bj][m][1] * f * gn[bj][1];
                    u32x4 w; w.x = pk2(a0[0], a0[1]); w.y = pk2(a0[2], a0[3]); w.z = pk2(a1[0], a1[1]); w.w = pk2(a1[2], a1[3]); *(u32x4*)(ob + (size_t)v * DM + 16 * fq + 8 * bj) = w; }
            }
    }
};

struct StoreF32 {
    float* C;
    __device__ __forceinline__ void operator()(AccRef acc, const Unit& u, int ui, int wr, int wc, int fr_, int fq_) const {
        int fr = fr_, fq = fq_; asm volatile("" : "+v"(fr), "+v"(fq));
#pragma unroll
        for (int ai = 0; ai < 2; ++ai)
#pragma unroll
            for (int m = 0; m < 4; ++m) { float* rp = C + (size_t)(u.pm * 256 + ai * 128 + wr * 64 + m * 16 + fr) * 256 + wc * 32 + 4 * fq;
#pragma unroll
                for (int bj = 0; bj < 2; ++bj)
#pragma unroll
                    for (int n = 0; n < 2; ++n) *(f32x4*)(rp + bj * 128 + n * 16) = acc[ai][bj][m][n]; }
    }
};

struct S5Out {
    bf16_t* yb; const bf16_t* ucat; const float* dsk;
    __device__ __forceinline__ void operator()(AccRef acc, const Unit& u, int ui, int wr, int wc, int fr_, int fq_) const {
        int fr = fr_, fq = fq_; asm volatile("" : "+v"(fr), "+v"(fq));
        const int g = u.pm >> 2; const f32x4 dv = *(const f32x4*)(dsk + 16 * g + 4 * fq);
#pragma unroll
        for (int ai = 0; ai < 2; ++ai) {
            u32x2 hw[4][2][2];
#pragma unroll
            for (int m = 0; m < 4; ++m) { const int R = u.pm * 256 + ai * 128 + wr * 64 + m * 16 + fr;
#pragma unroll
                for (int bj = 0; bj < 2; ++bj)
#pragma unroll
                    for (int n = 0; n < 2; ++n) hw[m][bj][n] = *(const u32x2*)(ucat + (size_t)R * 512 + (8 * bj + 2 * wc + n) * 16 + 4 * fq); }
            asm volatile("" ::: "memory");
#pragma unroll
            for (int m = 0; m < 4; ++m) {
                const int R = u.pm * 256 + ai * 128 + wr * 64 + m * 16 + fr, bc = R & 1023, b = bc >> 7, c = bc & 127;
#pragma unroll
                for (int bj = 0; bj < 2; ++bj)
#pragma unroll
                    for (int n = 0; n < 2; ++n) {
                        const int i = 8 * bj + 2 * wc + n; const u32x2 h2 = hw[m][bj][n];
                        const float hn[4] = {bflo(h2.x), bfhi(h2.x), bflo(h2.y), bfhi(h2.y)}; const f32x4 a = acc[ai][bj][m][n]; float o[4];
#pragma unroll
                        for (int e = 0; e < 4; ++e) { const float y = a[e] + dv[e] * hn[e]; const float z = 1.5957691216057308f * (y + 0.044715f * y * y * y); o[e] = y * sigmoidf_(z); }
                        u32x2 w; w.x = pk2(o[0], o[1]); w.y = pk2(o[2], o[3]);
                        *(u32x2*)(yb + (size_t)(b * 2048 + 16 * c + i) * DM + 16 * g + 4 * fq) = w;
                    }
            }
        }
    }
};
}
constexpr size_t MiB = 1u << 20;
constexpr size_t WS_CTL = 0, CTL_ZERO_BYTES = 64 * 1024;
constexpr size_t WS_SMALL = 1 * MiB;
constexpr size_t WS_AL = WS_SMALL, WS_BTAB = WS_SMALL + 128 * 1024;
constexpr size_t WS_WA = WS_SMALL + 256 * 1024, WS_WB = WS_SMALL + 320 * 1024, WS_TW = WS_SMALL + 384 * 1024;
constexpr size_t WS_WUP = 2 * MiB;
constexpr size_t WS_WDN = 46 * MiB;
constexpr size_t WS_WQK = 68 * MiB;
constexpr size_t WS_WOUT = 86 * MiB;
constexpr size_t WS_FH = 90 * MiB;
constexpr size_t WS_WGLU = 94 * MiB;
constexpr size_t WS_WO = 98 * MiB;
constexpr size_t WS_DFT = 100 * MiB;
constexpr size_t WS_ACAT = 116 * MiB;
constexpr size_t WS_BCAT = 132 * MiB;
constexpr size_t WS_XB = 140 * MiB;
constexpr size_t WS_R = 172 * MiB;
constexpr size_t WS_GT = WS_R;
constexpr size_t WS_RF = WS_R + 96 * MiB;
constexpr size_t WS_HD = WS_R;
constexpr size_t WS_UCAT = WS_R, WS_SBUF = WS_R + 64 * MiB, WS_YBUF = WS_R + 128 * MiB;
constexpr size_t WS_QC = WS_R, WS_KC = WS_R + 32 * MiB, WS_VC = WS_R + 64 * MiB, WS_OACC = WS_R + 96 * MiB, WS_LACC = WS_R + 128 * MiB;
constexpr size_t WS_SSP = 332 * MiB;
constexpr size_t WS_END = 348 * MiB;
constexpr int CW_BAR = 4096;
constexpr int CW_ADONE = 9216;
constexpr int CW_GMAP = 8192;

constexpr int RING_BYTES = 131072;
constexpr int LDS_WB_OFF = RING_BYTES, LDS_WB_ROW = 272, LDS_WB_BYTES = 64 * LDS_WB_ROW;
constexpr int LDSCTL_OFF = LDS_WB_OFF + LDS_WB_BYTES, MISC_OFF = LDSCTL_OFF + 320;
constexpr int LDS_BYTES = 163840;
constexpr int NWAVES = 8, NTHREADS = 512;

#define XB_TMO      128
#define XB_XCNT(j)  (256  + 64 * (j))
#define XB_XSUB(j)  (1280 + 64 * (j))
#define XB_XGEN(j)  (2304 + 64 * (j))
#define XB_TOP      3328
#define XB_TOPGEN   3392
#define XCD_BAR_WORDS 3456
#define XB_SPIN_CAP (1u << 20)
__device__ __forceinline__ unsigned xb_ld(unsigned* p)              { return __hip_atomic_load(p, __ATOMIC_RELAXED, __HIP_MEMORY_SCOPE_AGENT); }
__device__ __forceinline__ unsigned xb_add(unsigned* p, unsigned v) { return __hip_atomic_fetch_add(p, v, __ATOMIC_RELAXED, __HIP_MEMORY_SCOPE_AGENT); }
__device__ __forceinline__ unsigned xb_xcc_id() { return (unsigned)__builtin_amdgcn_s_getreg((3 << 11) | 20) & 0xFu; }
#define XB_SPIN(cond, bar) do { unsigned _sp = 0; while (cond) { __builtin_amdgcn_s_sleep(1); \
    if ((++_sp & 255u) == 0u) { if (xb_ld(&(bar)[XB_TMO])) break; if (_sp > XB_SPIN_CAP) { atomicAdd(&(bar)[XB_TMO], 1u); break; } } } } while (0)
struct XcdBarrier { unsigned* bar; unsigned x; volatile LAS unsigned* st; };
__device__ __forceinline__ XcdBarrier xcd_barrier_post(unsigned* bar, volatile LAS unsigned* st) {
    XcdBarrier b; b.bar = bar; b.x = xb_xcc_id(); b.st = st;
    if (threadIdx.x == 0) (void)xb_add(&bar[XB_XCNT(b.x)], 1u);
    return b;
}
__device__ __forceinline__ void xcd_barrier_complete(unsigned* bar, unsigned x, unsigned& nloc, unsigned& nx) {
    const unsigned G = gridDim.x * gridDim.y * gridDim.z;
    unsigned sum, cnt, mine, sp = 0u;
    for (;;) {
        sum = 0u; cnt = 0u; mine = 0u;
#pragma unroll
        for (unsigned j = 0; j < 16; ++j) { const unsigned c = xb_ld(&bar[XB_XCNT(j)]); sum += c; cnt += (c > 0u) ? 1u : 0u; mine = (j == x) ? c : mine; }
        if (sum == G) break;
        __builtin_amdgcn_s_sleep(1);
        if ((++sp & 255u) == 0u) { if (xb_ld(&bar[XB_TMO])) break; if (sp > XB_SPIN_CAP) { atomicAdd(&bar[XB_TMO], 1u); break; } }
    }
    nloc = mine > 0u ? mine : 1u; nx = cnt > 0u ? cnt : 1u;
}
__device__ __forceinline__ void xcd_barrier(const XcdBarrier& b, const bool local = false, const char* pf = nullptr, const unsigned pfrs = 0u) {
    asm volatile("s_waitcnt vmcnt(0)" ::: "memory");
    __syncthreads();
    unsigned t0 = 0u, t1 = 0u, t2 = 0u;
    if (pf != nullptr && threadIdx.x >= 64) {
        const int l = (int)threadIdx.x - 64;
        const char* p0 = pf + (size_t)(l >> 2) * pfrs + (l & 3) * 128;
        const char* p1 = pf + (size_t)((l + 448) >> 2) * pfrs + ((l + 448) & 3) * 128;
        asm volatile("global_load_dword %0, %1, off" : "=v"(t0) : "v"(p0) : "memory");
        asm volatile("global_load_dword %0, %1, off" : "=v"(t1) : "v"(p1) : "memory");
        if (l < 128) { const char* p2 = pf + (size_t)((l + 896) >> 2) * pfrs + ((l + 896) & 3) * 128; asm volatile("global_load_dword %0, %1, off" : "=v"(t2) : "v"(p2) : "memory"); }
    }
    if (threadIdx.x == 0) {
        unsigned* bar = b.bar;
        __builtin_amdgcn_s_waitcnt(0);
        unsigned nloc = b.st[0], nx = b.st[1];
        if (nloc == 0u) { xcd_barrier_complete(bar, b.x, nloc, nx); b.st[0] = nloc; b.st[1] = nx; }
        const unsigned old = xb_add(&bar[XB_XSUB(b.x)], 1u);
        const unsigned gen = old / nloc;
        if (old + 1u == (gen + 1u) * nloc) {
            __builtin_amdgcn_fence(__ATOMIC_RELEASE, "agent");
            asm volatile("s_waitcnt vmcnt(0)" ::: "memory");
            if (!local) {
                const unsigned og = xb_add(&bar[XB_TOP], 1u);
                const unsigned tg = og / nx;
                if (og + 1u == (tg + 1u) * nx) xb_add(&bar[XB_TOPGEN], 1u);
                else XB_SPIN(xb_ld(&bar[XB_TOPGEN]) == tg, bar);
            }
            __builtin_amdgcn_fence(__ATOMIC_ACQUIRE, "agent");
            xb_add(&bar[XB_XGEN(b.x)], 1u);
            asm volatile("s_waitcnt vmcnt(0)" ::: "memory");
        } else {
            XB_SPIN(xb_ld(&bar[XB_XGEN(b.x)]) == gen, bar);
            __builtin_amdgcn_fence(__ATOMIC_ACQUIRE, "agent");
            asm volatile("s_waitcnt vmcnt(0)" ::: "memory");
        }
    }
    __syncthreads();
    if (pf != nullptr) { asm volatile("s_waitcnt vmcnt(0)" ::: "memory"); asm volatile("" :: "v"(t0), "v"(t1), "v"(t2)); }
}

struct Args { const float* in[20]; float* out; unsigned char* ws; int ph_lo, ph_hi; };
typedef const __attribute__((address_space(4))) Args* KArgs;
struct Frame {
    LAS unsigned char* lds; int tid, lane, wave, vcu, G; KArgs ka;
    __device__ __forceinline__ const float* in(int i) const { return ka->in[i]; }
    __device__ __forceinline__ float* out() const { return ka->out; }
    __device__ __forceinline__ unsigned char* ws() const { return ka->ws; }
};
#define LDS_WAIT() asm volatile("s_waitcnt lgkmcnt(0)" ::: "memory")
__device__ __forceinline__ float wave_sum(float v) {
#pragma unroll
    for (int o = 1; o < 64; o <<= 1) v += __shfl_xor(v, o);
    return v;
}

__device__ __forceinline__ int colmap(int n, int cmode, int cpar) {
    if (cmode == 0) return n + cpar;
    if (cmode == 1) return ((n >> 4) & 1) * cpar + 128 * (n >> 8) + 32 * ((n >> 5) & 3) + 8 * ((n >> 2) & 3) + 4 * ((n >> 7) & 1) + (n & 3);
    if (cmode == 3) return (n & ~31) + 8 * ((n >> 2) & 3) + 4 * ((n >> 4) & 1) + (n & 3) + cpar;
    const int pn = n >> 8, bj = (n >> 7) & 1, wc = (n >> 5) & 3, i = n & 31;
    if (pn >= 8) return cpar * 3072 + 2048 + (4 * (pn & 3) + wc) * 64 + 32 * bj + 8 * ((n >> 2) & 3) + 4 * ((n >> 4) & 1) + (n & 3);
    return cpar * 3072 + (pn >> 2) * 1024 + (4 * (pn & 3) + wc) * 64 + 32 * bj + i;
}
__device__ __forceinline__ int fnet_freq(int p) { return p <= 63 ? p + 1 : (p == 64 ? 0 : p); }
struct TItem { const float* W; bf16_t* WT; const float* scale; int K, ldsrc, Nd, cmode, cpar, item, kperm; };
__device__ __forceinline__ void ti_load(const TItem& T, int lane, f32x4 (&v)[8]) {
    const int nblk = T.Nd / 32, kb = T.item / nblk, nb = T.item % nblk, k0 = 64 * kb, n0 = 32 * nb;
    const int c4 = lane & 7, kr = lane >> 3, scol = colmap(n0 + 4 * c4, T.cmode, T.cpar);
#pragma unroll
    for (int i = 0; i < 8; ++i) { const int kd = k0 + 8 * i + kr, ks_ = T.kperm ? (kd & ~127) + fnet_freq(kd & 127) : kd; v[i] = __builtin_nontemporal_load((const f32x4*)(T.W + (size_t)ks_ * T.ldsrc + scol)); }
}
__device__ __forceinline__ void ti_finish(const TItem& T, int lane, const f32x4 (&v)[8], LAS float* scr) {
    const int nblk = T.Nd / 32, kb = T.item / nblk, nb = T.item % nblk, k0 = 64 * kb, n0 = 32 * nb;
    const int c4 = lane & 7, kr = lane >> 3, c = lane & 7;
    f32x4 s0 = {1.f, 1.f, 1.f, 1.f}, s1 = s0;
    if (T.scale) { s0 = *(const f32x4*)(T.scale + k0 + 8 * c); s1 = *(const f32x4*)(T.scale + k0 + 8 * c + 4); }
#pragma unroll
    for (int i = 0; i < 8; ++i) { LAS float* d = scr + (8 * i + kr) * 33 + 4 * c4; d[0] = v[i][0]; d[1] = v[i][1]; d[2] = v[i][2]; d[3] = v[i][3]; }
    LDS_WAIT(); asm volatile("" ::: "memory");
#pragma unroll
    for (int j = 0; j < 4; ++j) { const int n = (lane >> 3) + 8 * j; const LAS float* s = scr + (8 * c) * 33 + n;
        u32x4 o; o.x = pk2(s[0 * 33] * s0[0], s[1 * 33] * s0[1]); o.y = pk2(s[2 * 33] * s0[2], s[3 * 33] * s0[3]); o.z = pk2(s[4 * 33] * s1[0], s[5 * 33] * s1[1]); o.w = pk2(s[6 * 33] * s1[2], s[7 * 33] * s1[3]);
        *(GAS u32x4*)(T.WT + (size_t)(n0 + n) * T.K + k0 + 8 * c) = o; }
    LDS_WAIT(); asm volatile("" ::: "memory");
}

__device__ __forceinline__ int t5_bucket(int rel) {
    const int n = rel < 0 ? -rel : rel; int bk;
    if (n < 8) bk = n; else if (n < 15) bk = 8; else if (n < 27) bk = 9; else if (n < 50) bk = 10; else if (n < 91) bk = 11; else if (n < 166) bk = 12; else if (n < 305) bk = 13; else if (n < 559) bk = 14; else bk = 15;
    return bk + (rel > 0 ? 16 : 0);
}

__device__ __forceinline__ void s5_prep_group(Frame& F, int g) {
    LAS float* apow = (LAS float*)F.lds;
    LAS float* bbar = apow + 2 * 17 * 64 * 2;
    LAS float* ccl = bbar + 2 * 64 * 16 * 2;
    LAS float* ktab = ccl + 2 * 16 * 64 * 2;
    const float* lre = F.in(4); const float* lim = F.in(5); const float* ldt = F.in(6); const float* bre = F.in(7); const float* bim = F.in(8); const float* cre = F.in(9); const float* cim = F.in(10);
    const int t = F.tid;
    if (t < 128) {
        const int d = t >> 6, n = t & 63, ix = (d * 64 + g) * 64 + n;
        const float lr = lre[ix], li = lim[ix], dt = expf(ldt[d * 64 + g]);
        float sn, cs; sincospif(li * dt * 0.3183098861837907f, &sn, &cs);
        const float em1 = expm1f(lr * dt), mag = em1 + 1.0f, ar = mag * cs, ai = mag * sn;
        float pr = 1.0f, pi = 0.0f;
        for (int tau = 0; tau <= 16; ++tau) { apow[((d * 17 + tau) * 64 + n) * 2] = pr; apow[((d * 17 + tau) * 64 + n) * 2 + 1] = pi; const float nr = pr * ar - pi * ai, ni = pr * ai + pi * ar; pr = nr; pi = ni; }
        ((float*)(F.ws() + WS_AL))[ix * 2] = apow[((d * 17 + 16) * 64 + n) * 2]; ((float*)(F.ws() + WS_AL))[ix * 2 + 1] = apow[((d * 17 + 16) * 64 + n) * 2 + 1];
        float sh, ch; sincospif(li * dt * 0.15915494309189535f, &sh, &ch);
        const float nr = em1 * cs - 2.0f * sh * sh, ni = ai;
        const float den = lr * lr + li * li;
        const float cr = (nr * lr + ni * li) / den, ci = (ni * lr - nr * li) / den;
        for (int q = 0; q < 16; ++q) { const float br = bre[(size_t)ix * 16 + q], bi = bim[(size_t)ix * 16 + q];
            bbar[((d * 64 + n) * 16 + q) * 2] = cr * br - ci * bi; bbar[((d * 64 + n) * 16 + q) * 2 + 1] = cr * bi + ci * br; }
    }
    for (int i = t; i < 2048; i += NTHREADS) { const int d = i >> 10, p = (i >> 6) & 15, n = i & 63; const size_t ix = ((size_t)(d * 64 + g) * 16 + p) * 64 + n; ccl[i * 2] = cre[ix]; ccl[i * 2 + 1] = cim[ix]; }
    __syncthreads();
    {
        const int d = t >> 8, p = (t >> 4) & 15, q = t & 15; float kacc[16];
#pragma unroll
        for (int tau = 0; tau < 16; ++tau) kacc[tau] = 0.f;
        for (int n = 0; n < 64; ++n) {
            const f32x2 c2 = *(const LAS f32x2*)(ccl + ((d * 16 + p) * 64 + n) * 2), b2 = *(const LAS f32x2*)(bbar + ((d * 64 + n) * 16 + q) * 2);
            const float er = c2[0] * b2[0] - c2[1] * b2[1], ei = c2[0] * b2[1] + c2[1] * b2[0];
#pragma unroll
            for (int tau = 0; tau < 16; ++tau) { const f32x2 a2 = *(const LAS f32x2*)(apow + ((d * 17 + tau) * 64 + n) * 2); kacc[tau] += er * a2[0] - ei * a2[1]; }
        }
#pragma unroll
        for (int tau = 0; tau < 16; ++tau) ktab[((d * 16 + tau) * 16 + p) * 16 + q] = kacc[tau];
    }
    __syncthreads();
    bf16_t* acat = (bf16_t*)(F.ws() + WS_ACAT) + (size_t)g * 256 * 512;
    for (int pc = t; pc < 256 * 64; pc += NTHREADS) {
        const int R = pc >> 6, c0 = (pc & 63) * 8, i = R >> 4, p = R & 15; float v[8];
        if (c0 < 256) { const int j = c0 >> 4, q0 = c0 & 15;
#pragma unroll
            for (int e = 0; e < 8; ++e) { float s = 0.f; if (j <= i) s += ktab[((0 * 16 + (i - j)) * 16 + p) * 16 + q0 + e]; if (j >= i) s += ktab[((1 * 16 + (j - i)) * 16 + p) * 16 + q0 + e]; v[e] = s; }
        } else { const int ci_ = c0 - 256, d = ci_ >> 7, part = (ci_ >> 6) & 1, n0 = ci_ & 63, tau = d == 0 ? i + 1 : 16 - i;
#pragma unroll
            for (int e = 0; e < 8; ++e) { const int n = n0 + e; const float cr = ccl[((d * 16 + p) * 64 + n) * 2], ci = ccl[((d * 16 + p) * 64 + n) * 2 + 1], ar = apow[((d * 17 + tau) * 64 + n) * 2], ai = apow[((d * 17 + tau) * 64 + n) * 2 + 1];
                v[e] = part == 0 ? (cr * ar - ci * ai) : -(cr * ai + ci * ar); }
        }
        u32x4 o; o.x = pk2(v[0], v[1]); o.y = pk2(v[2], v[3]); o.z = pk2(v[4], v[5]); o.w = pk2(v[6], v[7]);
        *(GAS u32x4*)(acat + (size_t)R * 512 + c0) = o;
    }
    bf16_t* bcat = (bf16_t*)(F.ws() + WS_BCAT) + (size_t)g * 256 * 256;
    for (int pc = t; pc < 256 * 32; pc += NTHREADS) {
        const int Rb = pc >> 5, c0 = (pc & 31) * 8, d = Rb >> 7, part = (Rb >> 6) & 1, n = Rb & 63, j = c0 >> 4, q0 = c0 & 15, tau = d == 0 ? 15 - j : j;
        const float ar = apow[((d * 17 + tau) * 64 + n) * 2], ai = apow[((d * 17 + tau) * 64 + n) * 2 + 1]; float v[8];
#pragma unroll
        for (int e = 0; e < 8; ++e) { const float br = bbar[((d * 64 + n) * 16 + q0 + e) * 2], bi = bbar[((d * 64 + n) * 16 + q0 + e) * 2 + 1]; v[e] = part == 0 ? (ar * br - ai * bi) : (ar * bi + ai * br); }
        u32x4 o; o.x = pk2(v[0], v[1]); o.y = pk2(v[2], v[3]); o.z = pk2(v[4], v[5]); o.w = pk2(v[6], v[7]);
        *(GAS u32x4*)(bcat + (size_t)Rb * 256 + c0) = o;
    }
    __syncthreads();
}

__device__ __forceinline__ void fh_item(Frame& F, int item) {
    const int ls = item >> 5, pn = (item >> 3) & 3, rg = item & 7, bj = rg >> 2, q = rg & 3, layer = ls == 0 ? 0 : 3, t = F.tid;
    bf16_t* dst = (bf16_t*)(F.ws() + WS_FH) + ((size_t)(ls * 4 + pn) * 256 + 32 * rg) * 256;
    const float* gn = F.in(1) + layer * DM + 256 * pn;
    for (int i = t; i < 32 * 256; i += NTHREADS) { const int r = i >> 8, kk = i & 255, part = r >> 4, ch = r & 15, m = kk & 127;
        float v = 0.f;
        if ((kk >> 7) == bj) {
            const bool special = (q == 3 && ch == 15); const int k = special ? (part ? 64 : 0) : 16 * q + 1 + ch;
            float sn, cs; sincospif((float)((k * m) & 127) * (1.0f / 64.0f), &sn, &cs);
            v = ((part && !special) ? sn : cs) * gn[kk] * 0.08838834764831845f; }
        dst[i] = (bf16_t)f2bf(v); }
}

__device__ __forceinline__ void dft_tables_item(Frame& F) {
    bf16_t* wa = (bf16_t*)(F.ws() + WS_WA); bf16_t* wb = (bf16_t*)(F.ws() + WS_WB); float* tw = (float*)(F.ws() + WS_TW);
    const int t = F.tid;
    for (int i = t; i < 64 * 64; i += NTHREADS) { const int r = i >> 6, k = i & 63, po = r >> 5, s1 = r & 31, pi = k >> 5, s1p = k & 31;
        float sn, cs; sincospif((float)((s1 * s1p) & 31) * (1.0f / 16.0f), &sn, &cs);
        const float v = po == 0 ? (pi == 0 ? cs : -sn) : (pi == 0 ? -sn : -cs); wa[i] = (bf16_t)f2bf(v); }
    for (int i = t; i < 64 * 128; i += NTHREADS) { const int s2 = i >> 7, k = i & 127, part = k >> 6, s2p = k & 63;
        float sn, cs; sincospif((float)((s2 * s2p) & 63) * (1.0f / 32.0f), &sn, &cs);
        wb[i] = (bf16_t)f2bf((part == 0 ? cs : sn) * 0.022097086912079608f); }
    for (int i = t; i < 32 * 64; i += NTHREADS) { const int s1 = i >> 6, s2p = i & 63; float sn, cs; sincospif((float)(s1 * s2p) * (1.0f / 1024.0f), &sn, &cs); tw[2 * i] = cs; tw[2 * i + 1] = sn; }
}

__device__ __forceinline__ TItem prep_item(Frame& F, int set, int it) {
    constexpr int I_UP = 16 * 176, I_DN = 44 * 32, I_QKV = 16 * 96, I_WO = 16 * 32, I_GLU = 16 * 64;
    const int l = set; int r = it; TItem T; T.kperm = 0;
    if (r < I_UP) { T.W = F.in(18) + (size_t)l * DM * 2 * DFF; T.K = DM; T.ldsrc = 2 * DFF; T.WT = (bf16_t*)(F.ws() + WS_WUP) + (size_t)l * 2 * DFF * DM; T.Nd = 2 * DFF; T.cmode = 1; T.cpar = DFF; T.scale = F.in(2) + l * DM; T.item = r; return T; } r -= I_UP;
    if (r < I_DN) { T.W = F.in(19) + (size_t)l * DFF * DM; T.K = DFF; T.ldsrc = DM; T.WT = (bf16_t*)(F.ws() + WS_WDN) + (size_t)l * DM * DFF; T.Nd = DM; T.cmode = 3; T.cpar = 0; T.scale = nullptr; T.item = r; return T; } r -= I_DN;
    if (set == 0 || set == 3) { const int js = set == 0 ? 0 : 1; T.W = F.in(3) + (size_t)js * DM * DM; T.K = DM; T.ldsrc = DM; T.WT = (bf16_t*)(F.ws() + WS_WOUT) + (size_t)js * DM * DM; T.Nd = DM; T.cmode = 3; T.cpar = 0; T.scale = nullptr; T.item = r; T.kperm = 1; return T; }
    if (set == 1) {
        if (r < I_GLU) { T.W = F.in(12); T.K = DM; T.ldsrc = 2 * DM; T.WT = (bf16_t*)(F.ws() + WS_WGLU); T.Nd = 2 * DM; T.cmode = 1; T.cpar = DM; T.scale = nullptr; T.item = r; return T; }
        T.W = F.in(16); T.K = DM; T.ldsrc = DM; T.WT = (bf16_t*)(F.ws() + WS_WO); T.Nd = DM; T.cmode = 3; T.cpar = 0; T.scale = nullptr; T.item = r - I_GLU; return T; }
    { const int g = r / I_QKV; T.W = F.in(13); T.K = DM; T.ldsrc = 9216; T.WT = (bf16_t*)(F.ws() + WS_WQK) + (size_t)g * 3072 * DM; T.Nd = 3072; T.cmode = 2; T.cpar = g; T.scale = F.in(1) + 2 * DM; T.item = r % I_QKV; return T; }
}
__device__ __forceinline__ void prep_transposes(Frame& F, int set, int gw, int NGW) {
    LAS float* scr = (LAS float*)(F.lds + F.wave * 16384);
    constexpr int I_UP = 16 * 176, I_DN = 44 * 32, I_QKV = 16 * 96, I_WO = 16 * 32, I_GLU = 16 * 64;
    const int nitems = I_UP + I_DN + (set == 1 ? I_GLU + I_WO : 0) + (set == 2 ? 3 * I_QKV : 0) + ((set == 0 || set == 3) ? I_WO : 0);
    if (gw >= nitems) return;
    TItem T = prep_item(F, set, gw); f32x4 v[8], vn[8];
    ti_load(T, F.lane, v);
    for (int it = gw; it < nitems; it += NGW) {
        const bool more = it + NGW < nitems; TItem Tn = T;
        if (more) { Tn = prep_item(F, set, it + NGW); ti_load(Tn, F.lane, vn); }
        ti_finish(T, F.lane, v, scr);
        if (more) { T = Tn;
#pragma unroll
            for (int i = 0; i < 8; ++i) v[i] = vn[i]; }
    }
}
__device__ __forceinline__ void prep_background(Frame& F, int L) {
    const int bb = (int)blockIdx.x - 128; if (bb < 0 || L > 2) return;
    if (L == 0) { if (bb < 64) { s5_prep_group(F, bb); __syncthreads(); } prep_transposes(F, 1, bb * NWAVES + F.wave, 128 * NWAVES); }
    else prep_transposes(F, L + 1, bb * NWAVES + F.wave, 128 * NWAVES);
    if (L == 2 && bb < 32) fh_item(F, 32 + bb);
}

__device__ __forceinline__ void phase_prep(Frame& F) {
    for (int it = F.vcu; it < 32 + 1; it += F.G) {
        if (it < 32) fh_item(F, it); else dft_tables_item(F);
    }
    __syncthreads();
    { const float* rb = F.in(17); float* bt = (float*)(F.ws() + WS_BTAB);
      for (int i = F.vcu * NTHREADS + F.tid; i < 48 * 192; i += F.G * NTHREADS) { const int gh = i / 192, rel = i % 192 - 96, g = gh >> 4, dil = g == 0 ? 1 : (g == 1 ? 4 : 16);
          float gq = 0.f, gk = 0.f; for (int d = 0; d < 64; ++d) { gq = fmaxf(gq, fabsf(F.in(14)[g * 64 + d])); gk = fmaxf(gk, fabsf(F.in(15)[g * 64 + d])); }
          const float cb = 8.0f * LOG2E * gq * gk;
          bt[i] = rel == -96 ? cb : ((rel >= -64 && rel <= 64) ? rb[t5_bucket(rel * dil) * 48 + gh] * LOG2E - cb : -1e30f); } }
    const int gw = F.vcu * NWAVES + F.wave, NGW = F.G * NWAVES;
    prep_transposes(F, 0, gw, NGW);
    { float* ss0 = (float*)(F.ws() + WS_SSP); bf16_t* xb = (bf16_t*)(F.ws() + WS_XB);
      for (int m0 = gw; m0 < MTOK; m0 += 4 * NGW) {
          f32x4 v[4][4];
#pragma unroll
          for (int r = 0; r < 4; ++r) { const GAS f32x4* xr = (const GAS f32x4*)(F.in(0) + (size_t)(m0 + r * NGW) * DM) + F.lane;
#pragma unroll
              for (int j = 0; j < 4; ++j) v[r][j] = __builtin_nontemporal_load(&xr[64 * j]); }
#pragma unroll
          for (int r = 0; r < 4; ++r) { const int m = m0 + r * NGW; float s = 0.f;
#pragma unroll
              for (int j = 0; j < 4; ++j) s += (v[r][j][0] * v[r][j][0] + v[r][j][1] * v[r][j][1]) + (v[r][j][2] * v[r][j][2] + v[r][j][3] * v[r][j][3]);
              s = wave_sum(s); if (F.lane < 16) ss0[(size_t)m * 32 + F.lane] = F.lane == 0 ? s : 0.f;
              GAS u32x2* o8 = (GAS u32x2*)(xb + (size_t)m * DM) + F.lane;
#pragma unroll
              for (int j = 0; j < 4; ++j) { u32x2 w; w.x = pk2(v[r][j][0], v[r][j][1]); w.y = pk2(v[r][j][2], v[r][j][3]); o8[64 * j] = w; } } } }
}

__device__ __forceinline__ void s5_gather(Frame& F, int pm) {
    const bf16_t* x = (const bf16_t*)(F.ws() + WS_XB); const float* ss = (const float*)(F.ws() + WS_SSP) + (size_t)2 * MTOK * 32; bf16_t* uc = (bf16_t*)(F.ws() + WS_UCAT);
    const int g = pm >> 2, t2 = 2 * (pm & 3);
    const float* gn = F.in(1) + 1 * DM + 16 * g;
    f32x4 gv[4];
#pragma unroll
    for (int j = 0; j < 4; ++j) gv[j] = *(const f32x4*)(gn + 4 * j);
    for (int i0 = 0; i0 < 8; i0 += 4) {
        u32x4 x0[4], x1[4]; float r[4];
#pragma unroll
        for (int i = 0; i < 4; ++i) { const int loc = F.tid + 512 * (i0 + i), tok = (t2 + (loc >> 11)) * 2048 + (loc & 2047);
            const u32x4* xp = (const u32x4*)(x + (size_t)tok * DM + 16 * g); x0[i] = xp[0]; x1[i] = xp[1]; r[i] = rstd_tok(ss, tok, 4); }
#pragma unroll
        for (int i = 0; i < 4; ++i) { const int loc = F.tid + 512 * (i0 + i), b = t2 + (loc >> 11), s = loc & 2047, c = s >> 4, jj = s & 15; f32x4 v[4];
            v[0] = (f32x4){bflo(x0[i].x), bfhi(x0[i].x), bflo(x0[i].y), bfhi(x0[i].y)} * gv[0] * r[i]; v[1] = (f32x4){bflo(x0[i].z), bfhi(x0[i].z), bflo(x0[i].w), bfhi(x0[i].w)} * gv[1] * r[i];
            v[2] = (f32x4){bflo(x1[i].x), bfhi(x1[i].x), bflo(x1[i].y), bfhi(x1[i].y)} * gv[2] * r[i]; v[3] = (f32x4){bflo(x1[i].z), bfhi(x1[i].z), bflo(x1[i].w), bfhi(x1[i].w)} * gv[3] * r[i];
            u32x4 o0, o1; o0.x = pk2(v[0][0], v[0][1]); o0.y = pk2(v[0][2], v[0][3]); o0.z = pk2(v[1][0], v[1][1]); o0.w = pk2(v[1][2], v[1][3]);
            o1.x = pk2(v[2][0], v[2][1]); o1.y = pk2(v[2][2], v[2][3]); o1.z = pk2(v[3][0], v[3][1]); o1.w = pk2(v[3][2], v[3][3]);
            bf16_t* dp = uc + ((size_t)(g * 1024 + b * 128 + c) * 512 + jj * 16);
            *(u32x4*)dp = o0; *(u32x4*)(dp + 8) = o1; }
    }
}
__device__ __forceinline__ void phase_s5scan(Frame& F, int pm) {
    if (F.wave >= 4) return;
    const int dir = F.wave & 1, b = 2 * (pm & 3) + (F.wave >> 1), g = pm >> 2, n = F.lane;
    const float* al = (const float*)(F.ws() + WS_AL) + ((size_t)(dir * 64 + g) * 64 + n) * 2; const float ar = al[0], ai = al[1];
    const float* sb = (const float*)(F.ws() + WS_SBUF) + (size_t)(g * 1024 + b * 128) * 256 + dir * 128 + n;
    bf16_t* uc = (bf16_t*)(F.ws() + WS_UCAT) + (size_t)(g * 1024 + b * 128) * 512 + 256 + dir * 128 + n;
    float hr = 0.f, hi = 0.f;
    for (int c8 = 0; c8 < 128; c8 += 8) {
        float sr[8], si[8];
#pragma unroll
        for (int k = 0; k < 8; ++k) { const int c = dir == 0 ? c8 + k : 127 - (c8 + k); sr[k] = sb[(size_t)c * 256]; si[k] = sb[(size_t)c * 256 + 64]; }
#pragma unroll
        for (int k = 0; k < 8; ++k) { const int c = dir == 0 ? c8 + k : 127 - (c8 + k);
            uc[(size_t)c * 512] = (bf16_t)f2bf(hr); uc[(size_t)c * 512 + 64] = (bf16_t)f2bf(hi);
            const float nr = ar * hr - ai * hi + sr[k], ni = ar * hi + ai * hr + si[k]; hr = nr; hi = ni; }
    }
}

typedef short v4i16_t __attribute__((ext_vector_type(4)));
__device__ __forceinline__ v4i16_t lds_tr(LAS unsigned char* p) { return __builtin_amdgcn_ds_read_tr16_b64_v4i16((LAS v4i16_t*)p); }
__device__ __forceinline__ void phase_fdft(Frame& F) {
    const int lane = F.lane, w = F.wave, c31 = lane & 31, h = lane >> 5, blk = (lane >> 4) & 1, q = (lane & 15) >> 2, p = lane & 3;
    const bf16_t* gt = (const bf16_t*)(F.ws() + WS_GT); bf16_t* rf = (bf16_t*)(F.ws() + WS_RF);
    const bf16_t* wa = (const bf16_t*)(F.ws() + WS_WA); const bf16_t* wb = (const bf16_t*)(F.ws() + WS_WB); const float* tw = (const float*)(F.ws() + WS_TW);
    LAS unsigned char* img = F.lds; LAS unsigned char* wbl = F.lds + LDS_WB_OFF;
    for (int i = F.tid; i < 64 * 16; i += NTHREADS) { const int r = i >> 4, ch = i & 15; *(LAS u32x4*)(wbl + r * LDS_WB_ROW + ch * 16) = *(const u32x4*)(wb + r * 128 + ch * 8); }
    {
        const int b = (int)blockIdx.x & 7, nblk = (int)blockIdx.x >> 3, it = b * 64 + nblk, jb = nblk >> 2, qs = nblk & 3;
        LAS bf16_t* stash = (LAS bf16_t*)(F.lds + LDSCTL_OFF + 4096);
        {
            const char* src = (const char*)(gt + (size_t)it * 65536) + lane * 16;
#pragma unroll
            for (int i = 0; i < 16; ++i) __builtin_amdgcn_global_load_lds((const unsigned*)(src + (w * 16 + i) * 1024), (LAS unsigned*)(img + (w * 16 + i) * 1024), 16, 0, 0);
            asm volatile("s_waitcnt vmcnt(0)" ::: "memory");
        }
        __syncthreads();
        {
            bf16x8 wf[2][4];
#pragma unroll
            for (int nt = 0; nt < 2; ++nt)
#pragma unroll
                for (int ks = 0; ks < 4; ++ks) wf[nt][ks] = *(const bf16x8*)(wa + (nt * 32 + c31) * 64 + 16 * ks + 8 * h);
            for (int cgi = 0; cgi < 4; ++cgi) {
                const int s2b = 2 * (w + 8 * cgi), s2r = s2b + blk;
                f32x16 acc[2] = {{}, {}};
#pragma unroll
                for (int ks = 0; ks < 4; ++ks) {
                    const int pi = ks >> 1, s1p0 = 16 * (ks & 1) + 8 * h + q;
                    LAS unsigned char* a0 = img + ((pi * 64 + s2r) * 32 + ((s1p0) ^ (blk << 2))) * 32 + 8 * p;
                    LAS unsigned char* a1 = img + ((pi * 64 + s2r) * 32 + ((s1p0 + 4) ^ (blk << 2))) * 32 + 8 * p;
                    const v4i16_t lo = lds_tr(a0), hi = lds_tr(a1);
                    const bf16x8 af = {lo[0], lo[1], lo[2], lo[3], hi[0], hi[1], hi[2], hi[3]};
#pragma unroll
                    for (int nt = 0; nt < 2; ++nt) acc[nt] = __builtin_amdgcn_mfma_f32_32x32x16_bf16(af, wf[nt][ks], acc[nt], 0, 0, 0);
                }
#pragma unroll
                for (int jj = 0; jj < 2; ++jj) {
                    const int s2 = s2b + jj; f32x2 cs; { float sn_, cs_; sincospif((float)(c31 * s2) * (1.0f / 1024.0f), &sn_, &cs_); cs[0] = cs_; cs[1] = sn_; }
#pragma unroll
                    for (int u2 = 0; u2 < 2; ++u2) {
                        const int tq = 2 * jj + u2, nq = 2 * u2 + h; float re[4], im[4];
#pragma unroll
                        for (int e = 0; e < 4; ++e) { const float tr = acc[0][4 * tq + e], ti = acc[1][4 * tq + e]; re[e] = tr * cs[0] + ti * cs[1]; im[e] = ti * cs[0] - tr * cs[1]; }
                        const int slot = (c31 ^ (((s2 & 3) * 4 + nq) * 2)) * 8;
                        u32x2 wr_, wi_; wr_.x = pk2(re[0], re[1]); wr_.y = pk2(re[2], re[3]); wi_.x = pk2(im[0], im[1]); wi_.y = pk2(im[2], im[3]);
                        *(LAS u32x2*)(img + ((0 * 64 + s2) * 4 + nq) * 256 + slot) = wr_;
                        *(LAS u32x2*)(img + ((1 * 64 + s2) * 4 + nq) * 256 + slot) = wi_;
                    }
                }
                asm volatile("s_waitcnt lgkmcnt(0)" ::: "memory");
            }
        }
        __syncthreads();
        {
            for (int sbi = 0; sbi < 2; ++sbi) {
                const int s1b = 2 * (w + 8 * sbi), s1r = s1b + blk;
                f32x16 acc[2] = {{}, {}}, aci[2] = {{}, {}};
#pragma unroll
                for (int ks = 0; ks < 8; ++ks) {
                    const int part = ks >> 2, s2p0 = 16 * (ks & 3) + 8 * h + q;
                    const int slot = (s1r ^ ((q * 4 + p) * 2)) * 8;
                    const v4i16_t lo = lds_tr(img + ((part * 64 + s2p0) * 4 + p) * 256 + slot), hi = lds_tr(img + ((part * 64 + s2p0 + 4) * 4 + p) * 256 + slot);
                    const bf16x8 af = {lo[0], lo[1], lo[2], lo[3], hi[0], hi[1], hi[2], hi[3]};
#pragma unroll
                    for (int nt = 0; nt < 2; ++nt) { const bf16x8 wfr = *(const LAS bf16x8*)(wbl + (nt * 32 + c31) * LDS_WB_ROW + 32 * ks + 16 * h);
                        acc[nt] = __builtin_amdgcn_mfma_f32_32x32x16_bf16(af, wfr, acc[nt], 0, 0, 0); }
                    if (qs == 3) {
#pragma unroll
                        for (int nt = 0; nt < 2; ++nt) { u32x4 wi = *(const LAS u32x4*)(wbl + (nt * 32 + c31) * LDS_WB_ROW + 32 * (ks ^ 4) + 16 * h);
                            if (part == 0) { wi.x ^= 0x80008000u; wi.y ^= 0x80008000u; wi.z ^= 0x80008000u; wi.w ^= 0x80008000u; }
                            aci[nt] = __builtin_amdgcn_mfma_f32_32x32x16_bf16(af, __builtin_bit_cast(bf16x8, wi), aci[nt], 0, 0, 0); }
                    }
                }
                asm volatile("" ::: "memory");
#pragma unroll
                for (int nt = 0; nt < 2; ++nt)
#pragma unroll
                    for (int x = 0; x < 2; ++x) {
                        const int s = s1b + x + 32 * (32 * nt + c31), tok = b * 2048 + s, tokm = b * 2048 + ((2048 - s) & 2047);
#pragma unroll
                        for (int u2 = 0; u2 < 2; ++u2) { const int tq = 2 * x + u2, nq = 2 * u2 + h;
                            u32x2 wv; wv.x = pk2(acc[nt][4 * tq + 0], acc[nt][4 * tq + 1]); wv.y = pk2(acc[nt][4 * tq + 2], acc[nt][4 * tq + 3]); *(u32x2*)(rf + (size_t)tok * DM + 128 * jb + 16 * qs + 4 * nq) = wv;
                            u32x2 wm; wm.x = pk2(acc[nt][4 * tq + 3], acc[nt][4 * tq + 2]); wm.y = pk2(acc[nt][4 * tq + 1], acc[nt][4 * tq + 0]); *(u32x2*)(rf + (size_t)tokm * DM + 128 * jb + 124 - 16 * qs - 4 * nq) = wm; }
                        if (qs == 3 && h == 1) { stash[s] = (bf16_t)f2bf(acc[nt][4 * (2 * x + 1) + 3]); stash[2048 + s] = (bf16_t)f2bf(aci[nt][4 * (2 * x + 1) + 3]); }
                    }
            }
        }
        if (qs == 3) {
            asm volatile("s_waitcnt vmcnt(0) lgkmcnt(0)" ::: "memory");
            __syncthreads();
            for (int s = F.tid; s < 2048; s += NTHREADS) { const int sm = (2048 - s) & 2047;
                const float ca = 0.5f * (bf2f(stash[s]) + bf2f(stash[sm])), cb = -0.5f * (bf2f(stash[2048 + s]) + bf2f(stash[2048 + sm]));
                bf16_t* o = rf + (size_t)(b * 2048 + s) * DM + 128 * jb; o[64] = (bf16_t)f2bf(ca); o[63] = (bf16_t)f2bf(cb); }
        }
        __syncthreads();
    }
}

constexpr int AT_KROW = 144, AT_VROW = 192, AT_KT = 0, AT_VT = 384 * AT_KROW, AT_TAB = AT_VT + 384 * AT_VROW;
__device__ __forceinline__ void phase_attn(Frame& F, int g) {
    const int dil = g == 0 ? 1 : (g == 1 ? 4 : 16), seg = 2048 / dil, lane = F.lane, q = lane & 31, h = lane >> 5, t = F.tid, w = F.wave;
    const bf16_t* Qc = (const bf16_t*)(F.ws() + WS_QC); const bf16_t* Kc = (const bf16_t*)(F.ws() + WS_KC); const bf16_t* Vc = (const bf16_t*)(F.ws() + WS_VC);
    bf16_t* oacc = (bf16_t*)(F.ws() + WS_OACC); float* lacc = (float*)(F.ws() + WS_LACC);
    LAS unsigned char* Kt = F.lds + AT_KT; LAS unsigned char* Vt = F.lds + AT_VT; LAS float* tab = (LAS float*)(F.lds + AT_TAB);
    const int vb = F.vcu, b = vb >> 5, hh = (vb >> 1) & 15, half = vb & 1;
    if (t < 192) tab[t] = ((const float*)(F.ws() + WS_BTAB))[(g * 16 + hh) * 192 + t];
    u32x4 kst[6], vst[6];
    const __amdgpu_buffer_rsrc_t krs = __builtin_amdgcn_make_buffer_rsrc((void*)(Kc + (size_t)b * 2048 * DM), 0, 2048 * 2048, 0x00020000);
    const __amdgpu_buffer_rsrc_t vrs = __builtin_amdgcn_make_buffer_rsrc((void*)(Vc + (size_t)b * 2048 * DM), 0, 2048 * 2048, 0x00020000);
    const int kvo = (t >> 3) * 2048 + hh * 128 + (t & 7) * 16;
    const int kls = (t >> 3) * AT_KROW + (t & 7) * 16, vls = (t >> 3) * AT_VROW + (t & 7) * 16;
#define AT_LOAD(cs_) do { _Pragma("unroll") for (int i = 0; i < 6; ++i) { \
        kst[i] = __builtin_bit_cast(u32x4, __builtin_amdgcn_raw_buffer_load_b128(krs, kvo, ((cs_) - 64 + 64 * i) * 2048, 0)); \
        vst[i] = __builtin_bit_cast(u32x4, __builtin_amdgcn_raw_buffer_load_b128(vrs, kvo, ((cs_) - 64 + 64 * i) * 2048, 0)); } } while (0)
#define AT_STORE() do { _Pragma("unroll") for (int i = 0; i < 6; ++i) { \
        *(LAS u32x4*)(Kt + kls + i * (64 * AT_KROW)) = kst[i]; *(LAS u32x4*)(Vt + vls + i * (64 * AT_VROW)) = vst[i]; } } while (0)
    AT_LOAD(half * 1024);
    bf16x8 qf[4], qn[4];
    { const bf16_t* qp = Qc + (size_t)(b * 2048 + half * 1024 + 32 * w + q) * DM + hh * 64 + 8 * h;
#pragma unroll
      for (int s = 0; s < 4; ++s) qf[s] = *(const bf16x8*)(qp + 16 * s); }
    AT_STORE();
    __syncthreads();
    for (int rd = 0; rd < 4; ++rd) {
        const int cs = half * 1024 + 256 * rd;
        if (rd < 3) AT_LOAD(cs + 256);
        const int vin0 = cs + 32 * w, r = vin0 / seg, m0 = vin0 & (seg - 1);
        const int tok = b * 2048 + (m0 + q) * dil + r;
        if (rd < 3) { const bf16_t* qp = Qc + (size_t)(b * 2048 + vin0 + 256 + q) * DM + hh * 64 + 8 * h;
#pragma unroll
            for (int s = 0; s < 4; ++s) qn[s] = *(const bf16x8*)(qp + 16 * s); }
        u32x2 old[2][4]; float lo = 0.f;
        if (g != 0) { lo = lacc[tok * 16 + hh];
#pragma unroll
            for (int db = 0; db < 2; ++db)
#pragma unroll
                for (int tq = 0; tq < 4; ++tq) old[db][tq] = *(const u32x2*)(oacc + (size_t)tok * DM + hh * 64 + 32 * db + 8 * tq + 4 * h); }
        f32x16 O[2] = {{}, {}}; float l = 0.f;
#pragma unroll
        for (int kb = 0; kb < 5; ++kb) {
            const int mk0 = m0 - 64 + 32 * kb; const bool valid = (mk0 >= 0) && (mk0 < seg);
            if (!valid) continue;
            const LAS unsigned char* kp = Kt + (32 * (w + kb) + q) * AT_KROW + 16 * h;
            f32x16 a = {};
#pragma unroll
            for (int s = 0; s < 4; ++s) { const bf16x8 kf = *(const LAS bf16x8*)(kp + 32 * s); a = __builtin_amdgcn_mfma_f32_32x32x16_bf16(kf, qf[s], a, 0, 0, 0); }
#pragma unroll
            for (int e = 0; e < 16; ++e) { const int key = (e & 3) + 8 * (e >> 2) + 4 * h; const float bias = tab[32 * kb - 64 + key - q + 96]; const float p = fast_exp2(a[e] + bias); a[e] = p; l += p; }
#pragma unroll
            for (int s2 = 0; s2 < 2; ++s2) {
                u32x4 pw; pw.x = pk2(a[8 * s2 + 0], a[8 * s2 + 1]); pw.y = pk2(a[8 * s2 + 2], a[8 * s2 + 3]); pw.z = pk2(a[8 * s2 + 4], a[8 * s2 + 5]); pw.w = pk2(a[8 * s2 + 6], a[8 * s2 + 7]);
                const bf16x8 pb = __builtin_bit_cast(bf16x8, pw);
#pragma unroll
                for (int db = 0; db < 2; ++db) {
                    LAS unsigned char* va = Vt + (32 * (w + kb) + 16 * s2 + 4 * h + ((lane & 15) >> 2)) * AT_VROW + (32 * db + 16 * ((lane >> 4) & 1) + 4 * (lane & 3)) * 2;
                    const v4i16_t lo = lds_tr(va), hi = lds_tr(va + 8 * AT_VROW);
                    const bf16x8 vf = {lo[0], lo[1], lo[2], lo[3], hi[0], hi[1], hi[2], hi[3]};
                    O[db] = __builtin_amdgcn_mfma_f32_32x32x16_bf16(vf, pb, O[db], 0, 0, 0);
                }
            }
            __builtin_amdgcn_sched_barrier(0);
        }
        l += __shfl_xor(l, 32);
        const float mx = tab[0];
        {
            const float inv = fast_rcp(l), lse = mx + __builtin_amdgcn_logf(l);
            float wo = 0.f, wn = 1.f, ln = lse;
            if (g != 0) { const float mm = fmaxf(lo, lse); ln = mm + __builtin_amdgcn_logf(fast_exp2(lo - mm) + fast_exp2(lse - mm)); wo = fast_exp2(lo - ln); wn = fast_exp2(lse - ln); }
            wn *= inv;
#pragma unroll
            for (int db = 0; db < 2; ++db)
#pragma unroll
                for (int tq = 0; tq < 4; ++tq) {
                    bf16_t* op = oacc + (size_t)tok * DM + hh * 64 + 32 * db + 8 * tq + 4 * h; float o[4];
#pragma unroll
                    for (int e = 0; e < 4; ++e) o[e] = O[db][4 * tq + e] * wn;
                    if (g != 0) { const u32x2 ow = old[db][tq]; o[0] += wo * bflo(ow.x); o[1] += wo * bfhi(ow.x); o[2] += wo * bflo(ow.y); o[3] += wo * bfhi(ow.y); }
                    u32x2 wv; wv.x = pk2(o[0], o[1]); wv.y = pk2(o[2], o[3]); *(u32x2*)op = wv;
                }
            if (h == 0) lacc[tok * 16 + hh] = ln;
        }
        __syncthreads();
        if (rd < 3) { AT_STORE(); __syncthreads();
#pragma unroll
            for (int s = 0; s < 4; ++s) qf[s] = qn[s]; }
    }
#undef AT_LOAD
#undef AT_STORE
}
#ifndef MK_ONE_LAUNCH
#define MK_ONE_LAUNCH 1
#endif
constexpr int NPHASES = 26;
enum PhaseKind { PK_PREP = 0, PK_G1, PK_G2, PK_UP, PK_DOWN, PK_S5PRE, PK_S5A, PK_S5SCAN, PK_S5C, PK_GLU, PK_QK, PK_ATT, PK_WO, PK_FC };
struct PhaseDesc { int kind, layer, g, nobar; };
__device__ __forceinline__ PhaseDesc phase_desc(int ph) {
    PhaseDesc d; d.g = 0; d.nobar = 0;
    if (ph == 0) { d.kind = PK_PREP; d.layer = 0; return d; }
    if (ph <= 5) { d.layer = 0; d.kind = ph == 1 ? PK_G1 : ph == 2 ? PK_G2 : ph == 3 ? PK_FC : ph == 4 ? PK_UP : PK_DOWN; return d; }
    if (ph <= 11) { d.layer = 1; d.kind = ph == 6 ? PK_S5A : ph == 7 ? PK_S5SCAN : ph == 8 ? PK_S5C : ph == 9 ? PK_GLU : ph == 10 ? PK_UP : PK_DOWN; d.nobar = (ph == 6 || ph == 7) ? 2 : 0; return d; }
    if (ph <= 20) { d.layer = 2; if (ph <= 17) { const int q = ph - 12; d.g = q >> 1; d.kind = (q & 1) ? PK_ATT : PK_QK; } else d.kind = ph == 18 ? PK_WO : ph == 19 ? PK_UP : PK_DOWN; return d; }
    d.layer = 3; d.kind = ph == 21 ? PK_G1 : ph == 22 ? PK_G2 : ph == 23 ? PK_FC : ph == 24 ? PK_UP : PK_DOWN; return d;
}

struct EpiAny {
    int pk, L, gg; LAS float* rl;
    __device__ __forceinline__ void pre(const pg8::StaticOrder& S) const {
        if (!(pk == PK_G1 || pk == PK_UP || pk == PK_QK)) return;
        KArgs ka = (KArgs)__builtin_amdgcn_kernarg_segment_ptr(); asm volatile("" : "+s"(ka));
        int t = threadIdx.x; asm volatile("" : "+v"(t));
        unsigned char* ws = ka->ws; const float* ssb = (const float*)(ws + WS_SSP);
        const float* ssq = pk == PK_G1 ? ssb + (size_t)(2 * L) * MTOK * 32 : pk == PK_UP ? ssb + (size_t)(2 * L + 1) * MTOK * 32 : ssb + (size_t)4 * MTOK * 32;
        const int ns4 = (pk == PK_UP && L == 1) ? 8 : 4, dil = gg == 0 ? 1 : (gg == 1 ? 4 : 16);
        pg8::Unit u;
        for (int i = 0; i < 8 && S.next(i, u); ++i) if (t < 256) {
            int tok;
            if (pk == PK_UP) tok = u.pm * 256 + t;
            else if (pk == PK_G1) tok = (u.pm >> 3) * 2048 + 64 * (t & 31) + (u.pm & 7) * 8 + (t >> 5);
            else tok = (u.pm >> 3) * 2048 + epi::tokmap((u.pm * 256 + t) & 2047, dil);
            rl[i * 256 + t] = rstd_tok(ssq, tok, ns4);
        }
    }
    __device__ __forceinline__ void operator()(epi::AccRef acc, const pg8::Unit& u, int ui, int wr, int wc, int fr, int fq) const {
        KArgs ka = (KArgs)__builtin_amdgcn_kernarg_segment_ptr(); asm volatile("" : "+s"(ka));
        unsigned char* ws = ka->ws; float* ssb = (float*)(ws + WS_SSP); bf16_t* xb = (bf16_t*)(ws + WS_XB);
        const int dil = gg == 0 ? 1 : (gg == 1 ? 4 : 16);
        switch (pk) {
        case PK_G1: { epi::FnetStore E{(bf16_t*)(ws + WS_GT), ssb + (size_t)(2 * L) * MTOK * 32, 4, rl}; E(acc, u, ui, wr, wc, fr, fq); } break;
        case PK_DOWN: { epi::Resid E{L == 3 ? ka->out : nullptr, xb, L < 3 ? ssb + (size_t)(2 * L + 2) * MTOK * 32 : nullptr, 0}; E(acc, u, ui, wr, wc, fr, fq); } break;
        case PK_GLU: { epi::Resid E{nullptr, xb, ssb + (size_t)3 * MTOK * 32, 1}; E(acc, u, ui, wr, wc, fr, fq); } break;
        case PK_WO: { epi::Resid E{nullptr, xb, ssb + (size_t)5 * MTOK * 32, 0}; E(acc, u, ui, wr, wc, fr, fq); } break;
        case PK_FC: { epi::Resid E{nullptr, xb, ssb + (size_t)(2 * L + 1) * MTOK * 32, 0}; E(acc, u, ui, wr, wc, fr, fq); } break;
        case PK_UP: {
            if (ui == 0 && L != 1) {
                unsigned* ctl = (unsigned*)(ws + WS_CTL);
                if (threadIdx.x == 0) XB_SPIN(xb_ld(ctl + CW_ADONE + 64 * L) < 256u, ctl + CW_BAR);
                __syncthreads();
            }
            epi::SwiGlu E{(bf16_t*)(ws + WS_HD), ssb + (size_t)(2 * L + 1) * MTOK * 32, L == 1 ? 8 : 4, rl}; E(acc, u, ui, wr, wc, fr, fq); } break;
        case PK_QK: { epi::QkNorm E{(bf16_t*)(ws + WS_QC), (bf16_t*)(ws + WS_KC), (bf16_t*)(ws + WS_VC), ssb + (size_t)4 * MTOK * 32, 4, ka->in[14] + gg * 64, ka->in[15] + gg * 64, dil, 0.125f * LOG2E, rl}; E(acc, u, ui, wr, wc, fr, fq); } break;
        case PK_S5A: { epi::StoreF32 E{(float*)(ws + WS_SBUF)}; E(acc, u, ui, wr, wc, fr, fq); } break;
        default: { epi::S5Out E{(bf16_t*)(ws + WS_YBUF), (const bf16_t*)(ws + WS_UCAT), ka->in[11]}; E(acc, u, ui, wr, wc, fr, fq); } break;
        }
    }
};

__global__ void __launch_bounds__(NTHREADS, 2) hybrid_fwd(Args args) {
    extern __shared__ __attribute__((aligned(16))) unsigned char lds_raw[];
    Frame F;
    F.lds = (LAS unsigned char*)lds_raw;
    F.tid = threadIdx.x; F.lane = F.tid & 63; F.wave = __builtin_amdgcn_readfirstlane(F.tid >> 6);
    F.G = gridDim.x; { const int bx = blockIdx.x; F.vcu = (F.G % 8 == 0) ? (bx % 8) * (F.G / 8) + bx / 8 : bx; }
    F.ka = (KArgs)__builtin_amdgcn_kernarg_segment_ptr();
    volatile LAS unsigned* MISC = (volatile LAS unsigned*)(F.lds + MISC_OFF);
    for (int u = F.tid; u < (LDS_BYTES - LDSCTL_OFF) / 4; u += NTHREADS) ((LAS unsigned*)(F.lds + LDSCTL_OFF))[u] = 0u;
    __syncthreads();
    unsigned* barw = (unsigned*)(F.ws() + WS_CTL) + CW_BAR;
    XcdBarrier bar; bar.bar = barw; bar.x = 0; bar.st = nullptr;
    const bool multi = (args.ph_hi - args.ph_lo) > 1;
    if (multi) bar = xcd_barrier_post(barw, MISC + 8);
    unsigned* gmap = (unsigned*)(F.ws() + WS_CTL) + CW_GMAP;
    if (multi && threadIdx.x == 0) (void)__hip_atomic_fetch_or(&gmap[64 * (blockIdx.x & 7)], 1u << bar.x, __ATOMIC_RELAXED, __HIP_MEMORY_SCOPE_AGENT);
    int grp_local = -1;

    int prev_kind = -1, prev_nobar = 0;
    for (int ph = args.ph_lo; ph < args.ph_hi; ++ph) {
        const PhaseDesc pd = phase_desc(ph);
        const int L = pd.layer;
        { KArgs k = (KArgs)__builtin_amdgcn_kernarg_segment_ptr(); asm volatile("" : "+s"(k)); F.ka = k; int t_ = threadIdx.x; asm volatile("" : "+v"(t_)); F.tid = t_; F.lane = t_ & 63; F.wave = __builtin_amdgcn_readfirstlane(t_ >> 6); }
        unsigned char* ws = F.ws();
        float* ssb = (float*)(ws + WS_SSP);
        bf16_t* xb = (bf16_t*)(ws + WS_XB);
        pg8::Geo g{}; EpiAny e; e.pk = pd.kind; e.L = L; e.gg = pd.g; bool is_gemm = true;
        g.rsA = g.rsB = DM * 2; g.hsA = g.hsB = 128 * DM * 2; g.tsA = g.tsB = (size_t)256 * DM * 2; g.K = DM;
        e.rl = (LAS float*)(F.lds + LDSCTL_OFF + 4096);
        switch (pd.kind) {
        case PK_G1:
            g.A = (const char*)xb; g.B = (const char*)(ws + WS_FH) + (size_t)(L == 0 ? 0 : 1) * 1024 * 256 * 2; g.nM = 64; g.nN = 4; g.modeA = 2; g.hsA = 4 * 2048;
            g.K = 256; g.kwA = 512; g.rsB = 512; g.hsB = 128 * 512; g.tsB = (size_t)256 * 512;
            break;
        case PK_FC:
            g.A = (const char*)(ws + WS_RF); g.B = (const char*)(ws + WS_WOUT) + (size_t)(L == 0 ? 0 : 1) * DM * DM * 2; g.nM = 64; g.nN = 4;
            break;
        case PK_UP:
            g.A = (const char*)xb; g.B = (const char*)(ws + WS_WUP) + (size_t)L * 2 * DFF * DM * 2; g.nM = 64; g.nN = 22;
            break;
        case PK_DOWN:
            g.A = (const char*)(ws + WS_HD); g.B = (const char*)(ws + WS_WDN) + (size_t)L * DM * DFF * 2; g.K = DFF; g.nM = 64; g.nN = 4;
            g.rsA = g.rsB = DFF * 2; g.hsA = g.hsB = 128 * DFF * 2; g.tsA = g.tsB = (size_t)256 * DFF * 2;
            break;
        case PK_S5A:
            g.A = (const char*)(ws + WS_UCAT); g.B = (const char*)(ws + WS_BCAT); g.K = 256; g.nM = 256; g.nN = 1;
            g.rsA = 1024; g.hsA = 128 * 1024; g.tsA = (size_t)256 * 1024; g.rsB = 512; g.hsB = 128 * 512; g.tsB = (size_t)256 * 512; g.bsel = 1;
            break;
        case PK_S5C:
            g.A = (const char*)(ws + WS_UCAT); g.B = (const char*)(ws + WS_ACAT); g.K = 512; g.nM = 256; g.nN = 1;
            g.rsA = 1024; g.hsA = 128 * 1024; g.tsA = (size_t)256 * 1024; g.rsB = 1024; g.hsB = 128 * 1024; g.tsB = (size_t)256 * 1024; g.bsel = 1;
            break;
        case PK_GLU:
            g.A = (const char*)(ws + WS_YBUF); g.B = (const char*)(ws + WS_WGLU); g.nM = 64; g.nN = 8;
            break;
        case PK_QK: {
            const int dil = pd.g == 0 ? 1 : (pd.g == 1 ? 4 : 16);
            g.A = (const char*)xb; g.B = (const char*)(ws + WS_WQK) + (size_t)pd.g * 3072 * DM * 2; g.nM = 64; g.nN = 12;
            g.modeA = 1; g.dil = dil; g.rsA = dil * 2048; g.hsA = dil == 16 ? 2048 : 128 * dil * 2048;
        } break;
        case PK_WO:
            g.A = (const char*)(ws + WS_OACC); g.B = (const char*)(ws + WS_WO); g.nM = 64; g.nN = 4;
            break;
        default: is_gemm = false; break;
        }
        pg8::StaticOrder S; S.init(g.nM, g.nN, F.G, (int)blockIdx.x);
        if (prev_nobar == 2) { asm volatile("s_waitcnt vmcnt(0)" ::: "memory"); __syncthreads(); }
        else if (prev_kind >= 0) {
            bool loc = prev_kind == PK_G1 || prev_kind == PK_G2 || prev_kind == PK_FC || prev_kind == PK_UP || prev_kind == PK_GLU || prev_kind == PK_QK || prev_kind == PK_ATT || prev_kind == PK_WO;
            if (loc && grp_local < 0) {
                unsigned ok = 1u;
#pragma unroll
                for (int j = 0; j < 8; ++j) { const unsigned m = xb_ld(&gmap[64 * j]); ok &= (m != 0u && (m & (m - 1u)) == 0u) ? 1u : 0u; }
                grp_local = __builtin_amdgcn_readfirstlane((int)ok);
            }
            const char* pf = nullptr; pg8::Unit u0;
            if (is_gemm && prev_kind != PK_PREP && prev_kind != PK_DOWN && S.next(0, u0)) pf = g.B + g.offB(u0);
            xcd_barrier(bar, loc && grp_local > 0, pf, g.rsB);
        }
        prev_kind = pd.kind; prev_nobar = pd.nobar;
        if (multi && threadIdx.x == 0 && (pd.kind == PK_FC || pd.kind == PK_WO)) (void)xb_add((unsigned*)(F.ws() + WS_CTL) + CW_ADONE + 64 * L, 1u);
        if (pd.kind == PK_S5A) { pg8::Unit u0; if (S.next(0, u0)) s5_gather(F, u0.pm); asm volatile("s_waitcnt vmcnt(0)" ::: "memory"); __syncthreads(); }
        if (is_gemm) {
            pg8::gemm_phase(F.lds, g, S, e);
            if (pd.kind == PK_UP) prep_background(F, L);
        }
#ifndef NO_PREP
        else if (pd.kind == PK_PREP) phase_prep(F);
#endif
#ifndef NO_S5X
        else if (pd.kind == PK_S5SCAN) { pg8::StaticOrder S; S.init(256, 1, F.G, (int)blockIdx.x); pg8::Unit u; if (S.next(0, u)) phase_s5scan(F, u.pm); }
#endif
#ifndef NO_ATTN
        else if (pd.kind == PK_ATT) phase_attn(F, pd.g);
#endif
        else if (pd.kind == PK_G2) phase_fdft(F);
        else {}
    }
}

extern "C" void kernel_launch(void* const* d_in, const int* in_sizes, int n_in, void* d_out, int out_size, void* d_ws, size_t ws_size, hipStream_t stream) {
    static int grid = 0;
    if (grid == 0) {
        if (n_in != 20 || in_sizes[0] != MTOK * DM || out_size != MTOK * DM || ws_size < WS_END) { fprintf(stderr, "kernel_launch: unexpected shapes / workspace (n_in %d, ws %zu)\n", n_in, ws_size); grid = -1; return; }
        int dev = 0, cus = 0, per_cu = 0;
        if (hipGetDevice(&dev) != hipSuccess || hipDeviceGetAttribute(&cus, hipDeviceAttributeMultiprocessorCount, dev) != hipSuccess) { grid = -1; return; }
        if (hipFuncSetAttribute((const void*)hybrid_fwd, hipFuncAttributeMaxDynamicSharedMemorySize, LDS_BYTES) != hipSuccess) { fprintf(stderr, "kernel_launch: hipFuncSetAttribute failed\n"); grid = -1; return; }
        if (hipOccupancyMaxActiveBlocksPerMultiprocessor(&per_cu, (const void*)hybrid_fwd, NTHREADS, LDS_BYTES) != hipSuccess || per_cu < 1) { fprintf(stderr, "kernel_launch: occupancy query reports %d\n", per_cu); }
        (void)hipGetLastError();
        if (cus < 256) { fprintf(stderr, "kernel_launch: built for 256 CUs with one resident workgroup each (got %d CUs); nothing launched\n", cus); grid = -1; return; }
        grid = 256;
    }
    if (grid < 0) return;
    (void)hipMemsetAsync((char*)d_ws + WS_CTL, 0, CTL_ZERO_BYTES, stream);
    Args a{};
    for (int i = 0; i < 20; ++i) a.in[i] = (const float*)d_in[i];
    a.out = (float*)d_out; a.ws = (unsigned char*)d_ws;
#if MK_ONE_LAUNCH
    a.ph_lo = 0; a.ph_hi = NPHASES;
    hipLaunchKernelGGL(hybrid_fwd, dim3(grid), dim3(NTHREADS), LDS_BYTES, stream, a);
#else
    for (int p = 0; p < NPHASES; ++p) { a.ph_lo = p; a.ph_hi = p + 1; hipLaunchKernelGGL(hybrid_fwd, dim3(grid), dim3(NTHREADS), LDS_BYTES, stream, a); }
#endif
}
```

```cpp
#include <hip/hip_runtime.h>
#include <cstdio>
#include <cstdint>

#define LAS __attribute__((address_space(3)))
#define GAS __attribute__((address_space(1)))
typedef unsigned short bf16_t;
typedef short bf16x8 __attribute__((ext_vector_type(8)));
typedef float f32x4 __attribute__((ext_vector_type(4)));
typedef float f32x2 __attribute__((ext_vector_type(2)));
typedef float f32x16 __attribute__((ext_vector_type(16)));
typedef unsigned u32x4 __attribute__((ext_vector_type(4)));
typedef unsigned u32x2 __attribute__((ext_vector_type(2)));
typedef GAS unsigned gu32;

constexpr int BATCH = 8, SEQ = 2048, DM = 1024, MTOK = BATCH * SEQ, DFF = 2816, DEPTH = 4;
constexpr float EPS = 1e-6f;
constexpr float LOG2E = 1.4426950408889634f;

__device__ __forceinline__ unsigned f2bf(float f) { unsigned u = __builtin_bit_cast(unsigned, f); return (u + 0x7fffu + ((u >> 16) & 1u)) >> 16; }
typedef __bf16 bf16x2_t __attribute__((ext_vector_type(2)));
__device__ __forceinline__ unsigned pk2(float lo, float hi) { const f32x2 v = {lo, hi}; return __builtin_bit_cast(unsigned, __builtin_convertvector(v, bf16x2_t)); }
__device__ __forceinline__ float bf2f(unsigned short h) { return __builtin_bit_cast(float, (unsigned)h << 16); }
__device__ __forceinline__ float bflo(unsigned w) { return __builtin_bit_cast(float, w << 16); }
__device__ __forceinline__ float bfhi(unsigned w) { return __builtin_bit_cast(float, w & 0xffff0000u); }
__device__ __forceinline__ float fast_rcp(float x) { return __builtin_amdgcn_rcpf(x); }
__device__ __forceinline__ float fast_exp2(float x) { return __builtin_amdgcn_exp2f(x); }
__device__ __forceinline__ float sigmoidf_(float x) { return fast_rcp(1.0f + fast_exp2(-LOG2E * x)); }
__device__ __forceinline__ float rstd_of(float ss) { return __builtin_amdgcn_rsqf(ss * (1.0f / DM) + EPS); }
template <int NS4> __device__ __forceinline__ float rstd_tok_u(const float* ssp, int tok) {
    const f32x4* p = (const f32x4*)(ssp + (size_t)tok * 32); f32x4 v[NS4];
#pragma unroll
    for (int i = 0; i < NS4; ++i) v[i] = p[i];
    float s = 0.f;
#pragma unroll
    for (int i = 0; i < NS4; ++i) s += (v[i][0] + v[i][1]) + (v[i][2] + v[i][3]);
    return rstd_of(s);
}
template <int NS4> __device__ __forceinline__ float rstd_tok_u64(const float* ssp, int tok) {
    const f32x4* p = (const f32x4*)(ssp + (size_t)tok * 64); f32x4 v[NS4];
#pragma unroll
    for (int i = 0; i < NS4; ++i) v[i] = p[i];
    float s = 0.f;
#pragma unroll
    for (int i = 0; i < NS4; ++i) s += (v[i][0] + v[i][1]) + (v[i][2] + v[i][3]);
    return rstd_of(s);
}
__device__ __forceinline__ float rstd_tok(const float* ssp, int tok, int ns4) { return ns4 == 16 ? rstd_tok_u64<16>(ssp, tok) : (ns4 == 8 ? rstd_tok_u<8>(ssp, tok) : rstd_tok_u<4>(ssp, tok)); }

namespace pg8 {
constexpr int BM = 256, BK = 64, HALF = 128, HTB = HALF * BK * 2  , STAGE_BYTES = 8 * HTB, NXCD = 8, WGM = 8;
__host__ __device__ __forceinline__ int lds_byte(int r, int c) { const int st = (r >> 4) * 2 + (c >> 5), rr = r & 15, cc = c & 31, ob = rr * 64 + cc * 2; return st * 1024 + (ob ^ (((ob >> 9) & 1) << 5)); }
__host__ __device__ __forceinline__ void stage_rc(int b, int& R, int& C) { const int st = b / 1024, sb = b % 1024, swz = sb ^ (((sb >> 9) & 1) << 5); R = (st >> 1) * 16 + swz / 64; C = (st & 1) * 32 + (swz % 64) / 2; }

struct Unit { int pm, pn; };
struct Geo {
    const char* A; const char* B; int K, nM, nN;
    unsigned rsA, rsB, hsA, hsB;
    size_t tsA, tsB;
    int modeA, modeB;
    int bsel;
    unsigned kwA;
    int dil;
    __device__ __forceinline__ size_t gather(int p) const {
        const int b = p >> 3, vin0 = (p & 7) * 256;
        const int tok0 = dil == 1 ? vin0 : (dil == 4 ? ((vin0 & 511) * 4 + (vin0 >> 9)) : (vin0 >> 7));
        return (size_t)(b * 2048 + tok0) * 2048u;
    }
    __device__ __forceinline__ size_t offA(const Unit& u) const { return (size_t)kwA * (unsigned)u.pn + (modeA == 2 ? (size_t)((u.pm >> 3) * 2048 + (u.pm & 7) * 8) * 2048u : (modeA ? gather(u.pm) : (size_t)u.pm * tsA)); }
    __device__ __forceinline__ size_t offB(const Unit& u) const { const int i = bsel ? (u.pm >> 2) : u.pn; return modeB ? gather(i) : (size_t)i * tsB; }
};
struct StaticOrder {
    int nM, nN, nwg, G, c;
    __device__ void init(int nM_, int nN_, int G_, int c_) { nM = nM_; nN = nN_; nwg = nM * nN; G = G_; c = c_; }
    __device__ bool next(int i, Unit& u) const {
        const long L = (long)i * G + c; if (L >= nwg) return false;
        int wgid = (int)L; { const int q = nwg / NXCD, r = nwg % NXCD, xcd = wgid % NXCD, off = wgid / NXCD; wgid = (xcd < r ? xcd * (q + 1) : r * (q + 1) + (xcd - r) * q) + off; }
        const int nig = WGM * nN, gid = wgid / nig, fm = gid * WGM, gsz = (nM - fm) < WGM ? (nM - fm) : WGM;
        u.pm = fm + ((wgid % nig) % gsz); u.pn = (wgid % nig) / gsz; return true;
    }
};

template <class Epi>
__device__ __forceinline__ void gemm_phase(LAS unsigned char* lds, const Geo g, const StaticOrder& S, const Epi& E) {
    int tid_ = threadIdx.x; asm volatile("" : "+v"(tid_));
    const int tid = tid_, wid = __builtin_amdgcn_readfirstlane(tid >> 6), lane = tid & 63, wr = wid >> 2, wc = wid & 3, fr = lane & 15, fq = lane >> 4;
    const int K = g.K, nt = K / BK;
    unsigned voffA[2], voffB[2];
#pragma unroll
    for (int i = 0; i < 2; ++i) { int R, C; stage_rc(tid * 16 + i * 8192, R, C); voffA[i] = (g.modeA == 2 ? (unsigned)((R & 31) * 64 + (R >> 5)) * 2048u : (unsigned)R * g.rsA) + (unsigned)C * 2u; voffB[i] = (unsigned)R * g.rsB + (unsigned)C * 2u; }
    const size_t kstep = (size_t)(BK * 2);
    const size_t hstepA = g.hsA, hstepB = g.hsB;
    const unsigned ldsw = (unsigned)wid * 1024u;
    const int aoff = lds_byte(wr * 64 + fr, fq * 8), boff = lds_byte(wc * 32 + fr, fq * 8);
#define PG8_SA(b, h) (((b) * 2 + (h)) * HTB)
#define PG8_SB(b, h) ((4 + (b) * 2 + (h)) * HTB)
#define PG8_STAGE(bufoff, gbase, voff) do { _Pragma("unroll") for (int _i = 0; _i < 2; ++_i) \
        __builtin_amdgcn_global_load_lds((const unsigned*)((const char*)(gbase) + (voff)[_i]), (LAS unsigned*)(lds + (bufoff) + ldsw + _i * 8192), 16, 0, 0); } while (0)
#define PG8_LDA(dst, b, h) do { _Pragma("unroll") for (int m = 0; m < 4; ++m) _Pragma("unroll") for (int k = 0; k < 2; ++k) dst[m][k] = *(const LAS bf16x8*)(lds + PG8_SA(b, h) + aoff + m * 2048 + k * 1024); } while (0)
#define PG8_LDB(dst, b, h) do { _Pragma("unroll") for (int n = 0; n < 2; ++n) _Pragma("unroll") for (int k = 0; k < 2; ++k) dst[n][k] = *(const LAS bf16x8*)(lds + PG8_SB(b, h) + boff + n * 2048 + k * 1024); } while (0)
#define PG8_MMA(ai, bj, At, Bt) do { __builtin_amdgcn_s_setprio(1); _Pragma("unroll") for (int m = 0; m < 4; ++m) _Pragma("unroll") for (int n = 0; n < 2; ++n) _Pragma("unroll") for (int k = 0; k < 2; ++k) \
        acc[ai][bj][m][n] = __builtin_amdgcn_mfma_f32_16x16x32_bf16(Bt[n][k], At[m][k], acc[ai][bj][m][n], 0, 0, 0); __builtin_amdgcn_s_setprio(0); } while (0)
#define PG8_WAIT_V(n) asm volatile("s_waitcnt vmcnt(" #n ")" ::: "memory")
#define PG8_WAIT_L(n) asm volatile("s_waitcnt lgkmcnt(" #n ")" ::: "memory")
#define PG8_BAR __builtin_amdgcn_s_barrier()
#define PG8_SCHED __builtin_amdgcn_sched_barrier(0)
    Unit cur, nxt; int ui = 0;
    if (!S.next(0, cur)) return;
    f32x4 acc[2][2][4][2];
#pragma unroll
    for (int a = 0; a < 2; ++a)
#pragma unroll
        for (int b = 0; b < 2; ++b)
#pragma unroll
            for (int m = 0; m < 4; ++m)
#pragma unroll
                for (int n = 0; n < 2; ++n) acc[a][b][m][n] = (f32x4){0.f, 0.f, 0.f, 0.f};
    bf16x8 At[4][2], B0[2][2], B1[2][2];
    const char* cA = g.A + g.offA(cur); const char* cB = g.B + g.offB(cur);
    PG8_STAGE(PG8_SB(0, 0), cB, voffB); PG8_STAGE(PG8_SB(0, 1), cB + hstepB, voffB); PG8_STAGE(PG8_SA(0, 0), cA, voffA); PG8_STAGE(PG8_SA(0, 1), cA + hstepA, voffA);
    E.pre(S);
    if (wr == 1) PG8_BAR;
    PG8_WAIT_V(2); PG8_BAR;
    PG8_STAGE(PG8_SB(1, 0), cB + kstep, voffB); PG8_STAGE(PG8_SA(1, 0), cA + kstep, voffA); PG8_STAGE(PG8_SB(1, 1), cB + hstepB + kstep, voffB);
    PG8_WAIT_V(6); PG8_BAR;
    for (;;) {
        const bool has_next = S.next(ui + 1, nxt);
        const char* nA = has_next ? g.A + g.offA(nxt) : cA; const char* nB = has_next ? g.B + g.offB(nxt) : cB;
        for (int t = 0; t < nt; t += 2) {
            const bool last = (t == nt - 2);
            const char* a1 = cA + (size_t)(t + 1) * kstep;
            const char* a2 = last ? nA : cA + (size_t)(t + 2) * kstep; const char* b2 = last ? nB : cB + (size_t)(t + 2) * kstep;
            const char* a3 = a2 + kstep; const char* b3 = b2 + kstep;
            PG8_LDB(B0, 0, 0); PG8_LDB(B1, 0, 1); PG8_SCHED; PG8_LDA(At, 0, 0); PG8_STAGE(PG8_SA(1, 1), a1 + hstepA, voffA);
            PG8_WAIT_V(8); PG8_WAIT_L(0); PG8_BAR; PG8_MMA(0, 0, At, B0); PG8_MMA(0, 1, At, B1); PG8_BAR; PG8_SCHED;
            PG8_LDA(At, 0, 1); PG8_STAGE(PG8_SB(0, 0), b2, voffB); PG8_STAGE(PG8_SB(0, 1), b2 + hstepB, voffB); PG8_STAGE(PG8_SA(0, 0), a2, voffA);
            PG8_WAIT_V(8); PG8_WAIT_L(0); PG8_BAR; PG8_MMA(1, 0, At, B0); PG8_MMA(1, 1, At, B1); PG8_BAR; PG8_SCHED;
            PG8_LDB(B0, 1, 0); PG8_LDB(B1, 1, 1); PG8_SCHED; PG8_LDA(At, 1, 0); PG8_STAGE(PG8_SA(0, 1), a2 + hstepA, voffA);
            PG8_WAIT_V(8); PG8_WAIT_L(0); PG8_BAR; PG8_MMA(0, 0, At, B0); PG8_MMA(0, 1, At, B1); PG8_BAR; PG8_SCHED;
            PG8_LDA(At, 1, 1); PG8_STAGE(PG8_SB(1, 0), b3, voffB); PG8_STAGE(PG8_SB(1, 1), b3 + hstepB, voffB); PG8_STAGE(PG8_SA(1, 0), a3, voffA);
            PG8_WAIT_V(8); PG8_WAIT_L(0); PG8_BAR; PG8_MMA(1, 0, At, B0); PG8_MMA(1, 1, At, B1); PG8_BAR; PG8_SCHED;
        }
        if (wr == 0) PG8_BAR;
        E(acc, cur, ui, wr, wc, fr, fq);
        if (!has_next) break;
#pragma unroll
        for (int a = 0; a < 2; ++a)
#pragma unroll
            for (int b = 0; b < 2; ++b)
#pragma unroll
                for (int m = 0; m < 4; ++m)
#pragma unroll
                    for (int n = 0; n < 2; ++n) acc[a][b][m][n] = (f32x4){0.f, 0.f, 0.f, 0.f};
        cur = nxt; cA = nA; cB = nB; ++ui;
        if (wr == 1) PG8_BAR;
    }
    PG8_WAIT_V(0);
    PG8_BAR;
#undef PG8_SA
#undef PG8_SB
#undef PG8_STAGE
#undef PG8_LDA
#undef PG8_LDB
#undef PG8_MMA
#undef PG8_WAIT_V
#undef PG8_WAIT_L
#undef PG8_BAR
#undef PG8_SCHED
}
}
namespace epi {
using pg8::Unit;
typedef const f32x4 (&AccRef)[2][2][4][2];

__device__ __forceinline__ int tokmap(int vin, int dil) {
    return dil == 1 ? vin : (dil == 4 ? ((vin & 511) * 4 + (vin >> 9)) : ((vin & 127) * 16 + (vin >> 7)));
}

struct ColScale {
    bf16_t* out; const float* ss; int ns4, mode, dil; LAS float* rl;
    __device__ __forceinline__ void operator()(AccRef acc, const Unit& u, int ui, int wr, int wc, int fr_, int fq_) const {
        int fr = fr_, fq = fq_; asm volatile("" : "+v"(fr), "+v"(fq));
        const int b = u.pn >> 3, cin0 = (u.pn & 7) * 256;
        f32x4 sc[2][2];
#pragma unroll
        for (int bj = 0; bj < 2; ++bj)
#pragma unroll
            for (int n = 0; n < 2; ++n) sc[bj][n] = *(const LAS f32x4*)(rl + ui * 256 + bj * 128 + wc * 32 + n * 16 + 4 * fq);
#pragma unroll
        for (int ai = 0; ai < 2; ++ai)
#pragma unroll
            for (int m = 0; m < 4; ++m) {
                const int row = u.pm * 256 + ai * 128 + wr * 64 + m * 16 + fr;
                bf16_t* rp;
                if (mode == 0) rp = out + ((size_t)(b * 1024 + (row & 1023)) * 4096 + (row >> 10) * 2048);
                else rp = out + (size_t)(b * 1024 + row) * 2048;
#pragma unroll
                for (int bj = 0; bj < 2; ++bj)
#pragma unroll
                    for (int n = 0; n < 2; ++n) {
                        const int cb = cin0 + wc * 32 + bj * 128 + n * 16;
                        const int c = mode == 0 ? cb + 4 * fq : cb + 8 * (fq & 1) + 4 * (fq >> 1);
                        const f32x4 v = acc[ai][bj][m][n] * sc[bj][n];
                        u32x2 w; w.x = pk2(v[0], v[1]); w.y = pk2(v[2], v[3]);
                        *(u32x2*)(rp + c) = w;
                    }
            }
    }
};

struct FnetStore {
    bf16_t* gt; const float* ss; int ns4; LAS float* rl;
    __device__ __forceinline__ void operator()(AccRef acc, const Unit& u, int ui, int wr, int wc, int fr_, int fq_) const {
        int fr = fr_, fq = fq_; asm volatile("" : "+v"(fr), "+v"(fq));
        const int b = u.pm >> 3, tb = (u.pm & 7) * 8;
#pragma unroll
        for (int ai = 0; ai < 2; ++ai)
#pragma unroll
            for (int m = 0; m < 4; ++m) {
                const int rl_ = ai * 128 + wr * 64 + m * 16 + fr, s2 = tb + (rl_ >> 5), cell = (rl_ & 31) ^ ((s2 & 1) << 2); const float r = rl[ui * 256 + rl_];
#pragma unroll
                for (int bj = 0; bj < 2; ++bj)
#pragma unroll
                    for (int n = 0; n < 2; ++n) {
                        const int nblk = 8 * u.pn + 4 * bj + wc;
                        const f32x4 v = acc[ai][bj][m][n] * r; u32x2 w; w.x = pk2(v[0], v[1]); w.y = pk2(v[2], v[3]);
                        *(u32x2*)(gt + ((((size_t)(b * 64 + nblk) * 2 + n) * 64 + s2) * 32 + cell) * 16 + 4 * fq) = w;
                    }
            }
    }
};

struct Resid {
    float* xout; bf16_t* xb; float* ssn; int glu;
    __device__ __forceinline__ void operator()(AccRef acc, const Unit& u, int ui, int wr, int wc, int fr_, int fq_) const {
        int fr = fr_, fq = fq_; asm volatile("" : "+v"(fr), "+v"(fq));
        const int row0 = u.pm * 256 + wr * 64 + fr;
#pragma unroll
        for (int ai = 0; ai < 2; ++ai) {
            u32x4 bs[4][2];
#pragma unroll
            for (int m = 0; m < 4; ++m) { const size_t ro = (size_t)(row0 + ai * 128 + m * 16) * DM;
                if (glu) { bs[m][0] = *(const u32x4*)(xb + ro + 128 * u.pn + 32 * wc + 8 * fq); bs[m][1] = (u32x4){0u, 0u, 0u, 0u}; }
                else {
#pragma unroll
                    for (int bj = 0; bj < 2; ++bj) bs[m][bj] = *(const u32x4*)(xb + ro + u.pn * 256 + bj * 128 + wc * 32 + 8 * fq); } }
            asm volatile("" ::: "memory");
#pragma unroll
            for (int m = 0; m < 4; ++m) {
                const int tok = row0 + ai * 128 + m * 16; const size_t ro = (size_t)tok * DM; float s2 = 0.f;
                if (glu) {
                    const int j = 128 * u.pn + 32 * wc + 8 * fq; const u32x4 b4 = bs[m][0]; float o[8];
                    const float bv[8] = {bflo(b4.x), bfhi(b4.x), bflo(b4.y), bfhi(b4.y), bflo(b4.z), bfhi(b4.z), bflo(b4.w), bfhi(b4.w)};
#pragma unroll
                    for (int bj = 0; bj < 2; ++bj)
#pragma unroll
                        for (int e = 0; e < 4; ++e) { const float v = bv[4 * bj + e] + acc[ai][bj][m][0][e] * sigmoidf_(acc[ai][bj][m][1][e]); o[4 * bj + e] = v; s2 += v * v; }
                    if (xout) { *(f32x4*)(xout + ro + j) = (f32x4){o[0], o[1], o[2], o[3]}; *(f32x4*)(xout + ro + j + 4) = (f32x4){o[4], o[5], o[6], o[7]}; }
                    else { u32x4 w; w.x = pk2(o[0], o[1]); w.y = pk2(o[2], o[3]); w.z = pk2(o[4], o[5]); w.w = pk2(o[6], o[7]); *(u32x4*)(xb + ro + j) = w; }
                } else {
#pragma unroll
                    for (int bj = 0; bj < 2; ++bj) {
                        const int c = u.pn * 256 + bj * 128 + wc * 32 + 8 * fq; const u32x4 b4 = bs[m][bj];
                        const f32x4 o0 = (f32x4){bflo(b4.x), bfhi(b4.x), bflo(b4.y), bfhi(b4.y)} + acc[ai][bj][m][0], o1 = (f32x4){bflo(b4.z), bfhi(b4.z), bflo(b4.w), bfhi(b4.w)} + acc[ai][bj][m][1];
                        s2 += ((o0[0] * o0[0] + o0[1] * o0[1]) + (o0[2] * o0[2] + o0[3] * o0[3])) + ((o1[0] * o1[0] + o1[1] * o1[1]) + (o1[2] * o1[2] + o1[3] * o1[3]));
                        if (xout) { __builtin_nontemporal_store(o0, (f32x4*)(xout + ro + c)); __builtin_nontemporal_store(o1, (f32x4*)(xout + ro + c + 4)); }
                        else { u32x4 w; w.x = pk2(o0[0], o0[1]); w.y = pk2(o0[2], o0[3]); w.z = pk2(o1[0], o1[1]); w.w = pk2(o1[2], o1[3]); *(u32x4*)(xb + ro + c) = w; }
                    }
                }
                s2 += __shfl_xor(s2, 16); s2 += __shfl_xor(s2, 32);
                if (fq == 0 && ssn) ssn[(size_t)tok * 32 + u.pn * 4 + wc] = s2;
            }
        }
    }
};

struct SwiGlu {
    bf16_t* hd; const float* ss; int ns4; LAS float* rl;
    __device__ __forceinline__ void operator()(AccRef acc, const Unit& u, int ui, int wr, int wc, int fr_, int fq_) const {
        int fr = fr_, fq = fq_; asm volatile("" : "+v"(fr), "+v"(fq));
#pragma unroll
        for (int ai = 0; ai < 2; ++ai)
#pragma unroll
            for (int m = 0; m < 4; ++m) {
                const int rl_ = ai * 128 + wr * 64 + m * 16 + fr, tok = u.pm * 256 + rl_; const float r = rl[ui * 256 + rl_]; float h[8];
#pragma unroll
                for (int bj = 0; bj < 2; ++bj) {
                    const f32x4 ga = acc[ai][bj][m][0], ua = acc[ai][bj][m][1];
#pragma unroll
                    for (int e = 0; e < 4; ++e) { const float gg = r * ga[e]; h[4 * bj + e] = gg * sigmoidf_(gg) * (r * ua[e]); }
                }
                u32x4 w; w.x = pk2(h[0], h[1]); w.y = pk2(h[2], h[3]); w.z = pk2(h[4], h[5]); w.w = pk2(h[6], h[7]);
                *(u32x4*)(hd + (size_t)tok * DFF + 128 * u.pn + 32 * wc + 8 * fq) = w;
            }
    }
};

struct QkNorm {
    bf16_t* qc; bf16_t* kc; bf16_t* vc; const float* ss; int ns4; const float* qgain; const float* kgain; int dil; float qscale; LAS float* rl;
    __device__ __forceinline__ void operator()(AccRef acc, const Unit& u, int ui, int wr, int wc, int fr_, int fq_) const {
        int fr = fr_, fq = fq_; asm volatile("" : "+v"(fr), "+v"(fq));
        const int which = u.pn >> 2, hh = 4 * (u.pn & 3) + wc;
        if (which == 2) {
#pragma unroll
            for (int ai = 0; ai < 2; ++ai)
#pragma unroll
                for (int m = 0; m < 4; ++m) { const int rl_ = ai * 128 + wr * 64 + m * 16 + fr; const float r = rl[ui * 256 + rl_];
#pragma unroll
                    for (int bj = 0; bj < 2; ++bj) { const f32x4 a0 = acc[ai][bj][m][0] * r, a1 = acc[ai][bj][m][1] * r;
                        u32x4 w; w.x = pk2(a0[0], a0[1]); w.y = pk2(a0[2], a0[3]); w.z = pk2(a1[0], a1[1]); w.w = pk2(a1[2], a1[3]);
                        *(u32x4*)(vc + (size_t)(u.pm * 256 + rl_) * DM + hh * 64 + 32 * bj + 8 * fq) = w; } }
            return;
        }
        const float* gp = which ? kgain : qgain; const float osc = which ? 1.0f : qscale;
        bf16_t* ob = (which ? kc : qc) + hh * 64;
        f32x4 gn[2][2];
#pragma unroll
        for (int bj = 0; bj < 2; ++bj)
#pragma unroll
            for (int n = 0; n < 2; ++n) gn[bj][n] = *(const f32x4*)(gp + 32 * bj + 16 * n + 4 * fq) * osc;
        const int b = u.pm >> 3;
#pragma unroll
        for (int ai = 0; ai < 2; ++ai)
#pragma unroll
            for (int m = 0; m < 4; ++m) {
                const int rl_ = ai * 128 + wr * 64 + m * 16 + fr; const int v = u.pm * 256 + rl_;
                const float r = rl[ui * 256 + rl_]; float s2 = 0.f;
#pragma unroll
                for (int bj = 0; bj < 2; ++bj)
#pragma unroll
                    for (int n = 0; n < 2; ++n) { const f32x4 a = acc[ai][bj][m][n]; s2 += (a[0] * a[0] + a[1] * a[1]) + (a[2] * a[2] + a[3] * a[3]); }
                s2 += __shfl_xor(s2, 16); s2 += __shfl_xor(s2, 32);
                const float f = r * __builtin_amdgcn_rsqf(r * r * s2 * (1.0f / 64.0f) + EPS);
#pragma unroll
                for (int bj = 0; bj < 2; ++bj) { const f32x4 a0 = acc[ai][bj][m][0] * f * gn[bj][0], a1 = acc[ai][bj][m][1] * f * gn[bj][1];
                    u32x4 w; w.x = pk2(a0[0], a0[1]); w.y = pk2(a0[2], a0[3]); w.z = pk2(a1[0], a1[1]); w.w = pk2(a1[2], a1[3]); *(u32x4*)(ob + (size_t)v * DM + 16 * fq + 8 * bj) = w; }
            }
    }
};

struct StoreF32 {
    float* C;
    __device__ __forceinline__ void operator()(AccRef acc, const Unit& u, int ui, int wr, int wc, int fr_, int fq_) const {
        int fr = fr_, fq = fq_; asm volatile("" : "+v"(fr), "+v"(fq));
#pragma unroll
        for (int ai = 0; ai < 2; ++ai)
#pragma unroll
            for (int m = 0; m < 4; ++m) { float* rp = C + (size_t)(u.pm * 256 + ai * 128 + wr * 64 + m * 16 + fr) * 256 + wc * 32 + 4 * fq;
#pragma unroll
                for (int bj = 0; bj < 2; ++bj)
#pragma unroll
                    for (int n = 0; n < 2; ++n) *(f32x4*)(rp + bj * 128 + n * 16) = acc[ai][bj][m][n]; }
    }
};

struct S5Out {
    bf16_t* yb; const bf16_t* ucat; const float* dsk;
    __device__ __forceinline__ void operator()(AccRef acc, const Unit& u, int ui, int wr, int wc, int fr_, int fq_) const {
        int fr = fr_, fq = fq_; asm volatile("" : "+v"(fr), "+v"(fq));
        const int g = u.pm >> 2; const f32x4 dv = *(const f32x4*)(dsk + 16 * g + 4 * fq);
#pragma unroll
        for (int ai = 0; ai < 2; ++ai) {
            u32x2 hw[4][2][2];
#pragma unroll
            for (int m = 0; m < 4; ++m) { const int R = u.pm * 256 + ai * 128 + wr * 64 + m * 16 + fr;
#pragma unroll
                for (int bj = 0; bj < 2; ++bj)
#pragma unroll
                    for (int n = 0; n < 2; ++n) hw[m][bj][n] = *(const u32x2*)(ucat + (size_t)R * 512 + (8 * bj + 2 * wc + n) * 16 + 4 * fq); }
            asm volatile("" ::: "memory");
#pragma unroll
            for (int m = 0; m < 4; ++m) {
                const int R = u.pm * 256 + ai * 128 + wr * 64 + m * 16 + fr, bc = R & 1023, b = bc >> 7, c = bc & 127;
#pragma unroll
                for (int bj = 0; bj < 2; ++bj)
#pragma unroll
                    for (int n = 0; n < 2; ++n) {
                        const int i = 8 * bj + 2 * wc + n; const u32x2 h2 = hw[m][bj][n];
                        const float hn[4] = {bflo(h2.x), bfhi(h2.x), bflo(h2.y), bfhi(h2.y)}; const f32x4 a = acc[ai][bj][m][n]; float o[4];
#pragma unroll
                        for (int e = 0; e < 4; ++e) { const float y = a[e] + dv[e] * hn[e]; const float z = 1.5957691216057308f * (y + 0.044715f * y * y * y); o[e] = y * sigmoidf_(z); }
                        u32x2 w; w.x = pk2(o[0], o[1]); w.y = pk2(o[2], o[3]);
                        *(u32x2*)(yb + (size_t)(b * 2048 + 16 * c + i) * DM + 16 * g + 4 * fq) = w;
                    }
            }
        }
    }
};
}
constexpr size_t MiB = 1u << 20;
constexpr size_t WS_CTL = 0, CTL_ZERO_BYTES = 64 * 1024;
constexpr size_t WS_SMALL = 1 * MiB;
constexpr size_t WS_AL = WS_SMALL, WS_BTAB = WS_SMALL + 128 * 1024;
constexpr size_t WS_WA = WS_SMALL + 256 * 1024, WS_WB = WS_SMALL + 320 * 1024, WS_TW = WS_SMALL + 384 * 1024;
constexpr size_t WS_WUP = 2 * MiB;
constexpr size_t WS_WDN = 46 * MiB;
constexpr size_t WS_WQK = 68 * MiB;
constexpr size_t WS_WOUT = 86 * MiB;
constexpr size_t WS_FH = 90 * MiB;
constexpr size_t WS_WGLU = 94 * MiB;
constexpr size_t WS_WO = 98 * MiB;
constexpr size_t WS_DFT = 100 * MiB;
constexpr size_t WS_ACAT = 116 * MiB;
constexpr size_t WS_BCAT = 132 * MiB;
constexpr size_t WS_XB = 140 * MiB;
constexpr size_t WS_R = 172 * MiB;
constexpr size_t WS_GT = WS_R;
constexpr size_t WS_RF = WS_R + 96 * MiB;
constexpr size_t WS_HD = WS_R;
constexpr size_t WS_UCAT = WS_R, WS_SBUF = WS_R + 64 * MiB, WS_YBUF = WS_R + 128 * MiB;
constexpr size_t WS_QC = WS_R, WS_KC = WS_R + 32 * MiB, WS_VC = WS_R + 64 * MiB, WS_OACC = WS_R + 96 * MiB, WS_LACC = WS_R + 128 * MiB;
constexpr size_t WS_SSP = 332 * MiB;
constexpr size_t WS_END = 348 * MiB;
constexpr int CW_BAR = 4096;
constexpr int CW_ADONE = 9216;
constexpr int CW_GMAP = 8192;

constexpr int RING_BYTES = 131072;
constexpr int LDS_WB_OFF = RING_BYTES, LDS_WB_ROW = 272, LDS_WB_BYTES = 64 * LDS_WB_ROW;
constexpr int LDSCTL_OFF = LDS_WB_OFF + LDS_WB_BYTES, MISC_OFF = LDSCTL_OFF + 320;
constexpr int LDS_BYTES = 163840;
constexpr int NWAVES = 8, NTHREADS = 512;

#define XB_TMO      128
#define XB_XCNT(j)  (256  + 64 * (j))
#define XB_XSUB(j)  (1280 + 64 * (j))
#define XB_XGEN(j)  (2304 + 64 * (j))
#define XB_TOP      3328
#define XB_TOPGEN   3392
#define XCD_BAR_WORDS 3456
#define XB_SPIN_CAP (1u << 20)
__device__ __forceinline__ unsigned xb_ld(unsigned* p)              { return __hip_atomic_load(p, __ATOMIC_RELAXED, __HIP_MEMORY_SCOPE_AGENT); }
__device__ __forceinline__ unsigned xb_add(unsigned* p, unsigned v) { return __hip_atomic_fetch_add(p, v, __ATOMIC_RELAXED, __HIP_MEMORY_SCOPE_AGENT); }
__device__ __forceinline__ unsigned xb_xcc_id() { return (unsigned)__builtin_amdgcn_s_getreg((3 << 11) | 20) & 0xFu; }
#define XB_SPIN(cond, bar) do { unsigned _sp = 0; while (cond) { __builtin_amdgcn_s_sleep(1); \
    if ((++_sp & 255u) == 0u) { if (xb_ld(&(bar)[XB_TMO])) break; if (_sp > XB_SPIN_CAP) { atomicAdd(&(bar)[XB_TMO], 1u); break; } } } } while (0)
struct XcdBarrier { unsigned* bar; unsigned x; volatile LAS unsigned* st; };
__device__ __forceinline__ XcdBarrier xcd_barrier_post(unsigned* bar, volatile LAS unsigned* st) {
    XcdBarrier b; b.bar = bar; b.x = xb_xcc_id(); b.st = st;
    if (threadIdx.x == 0) (void)xb_add(&bar[XB_XCNT(b.x)], 1u);
    return b;
}
__device__ __forceinline__ void xcd_barrier_complete(unsigned* bar, unsigned x, unsigned& nloc, unsigned& nx) {
    const unsigned G = gridDim.x * gridDim.y * gridDim.z;
    unsigned sum, cnt, mine, sp = 0u;
    for (;;) {
        sum = 0u; cnt = 0u; mine = 0u;
#pragma unroll
        for (unsigned j = 0; j < 16; ++j) { const unsigned c = xb_ld(&bar[XB_XCNT(j)]); sum += c; cnt += (c > 0u) ? 1u : 0u; mine = (j == x) ? c : mine; }
        if (sum == G) break;
        __builtin_amdgcn_s_sleep(1);
        if ((++sp & 255u) == 0u) { if (xb_ld(&bar[XB_TMO])) break; if (sp > XB_SPIN_CAP) { atomicAdd(&bar[XB_TMO], 1u); break; } }
    }
    nloc = mine > 0u ? mine : 1u; nx = cnt > 0u ? cnt : 1u;
}
__device__ __forceinline__ void xcd_barrier(const XcdBarrier& b, const bool local = false, const char* pf = nullptr, const unsigned pfrs = 0u) {
    asm volatile("s_waitcnt vmcnt(0)" ::: "memory");
    __syncthreads();
    unsigned t0 = 0u, t1 = 0u, t2 = 0u;
    if (pf != nullptr && threadIdx.x >= 64) {
        const int l = (int)threadIdx.x - 64;
        const char* p0 = pf + (size_t)(l >> 2) * pfrs + (l & 3) * 128;
        const char* p1 = pf + (size_t)((l + 448) >> 2) * pfrs + ((l + 448) & 3) * 128;
        asm volatile("global_load_dword %0, %1, off" : "=v"(t0) : "v"(p0) : "memory");
        asm volatile("global_load_dword %0, %1, off" : "=v"(t1) : "v"(p1) : "memory");
        if (l < 128) { const char* p2 = pf + (size_t)((l + 896) >> 2) * pfrs + ((l + 896) & 3) * 128; asm volatile("global_load_dword %0, %1, off" : "=v"(t2) : "v"(p2) : "memory"); }
    }
    if (threadIdx.x == 0) {
        unsigned* bar = b.bar;
        __builtin_amdgcn_s_waitcnt(0);
        unsigned nloc = b.st[0], nx = b.st[1];
        if (nloc == 0u) { xcd_barrier_complete(bar, b.x, nloc, nx); b.st[0] = nloc; b.st[1] = nx; }
        const unsigned old = xb_add(&bar[XB_XSUB(b.x)], 1u);
        const unsigned gen = old / nloc;
        if (old + 1u == (gen + 1u) * nloc) {
            __builtin_amdgcn_fence(__ATOMIC_RELEASE, "agent");
            asm volatile("s_waitcnt vmcnt(0)" ::: "memory");
            if (!local) {
                const unsigned og = xb_add(&bar[XB_TOP], 1u);
                const unsigned tg = og / nx;
                if (og + 1u == (tg + 1u) * nx) xb_add(&bar[XB_TOPGEN], 1u);
                else XB_SPIN(xb_ld(&bar[XB_TOPGEN]) == tg, bar);
            }
            __builtin_amdgcn_fence(__ATOMIC_ACQUIRE, "agent");
            xb_add(&bar[XB_XGEN(b.x)], 1u);
            asm volatile("s_waitcnt vmcnt(0)" ::: "memory");
        } else {
            XB_SPIN(xb_ld(&bar[XB_XGEN(b.x)]) == gen, bar);
            __builtin_amdgcn_fence(__ATOMIC_ACQUIRE, "agent");
            asm volatile("s_waitcnt vmcnt(0)" ::: "memory");
        }
    }
    __syncthreads();
    if (pf != nullptr) { asm volatile("s_waitcnt vmcnt(0)" ::: "memory"); asm volatile("" :: "v"(t0), "v"(t1), "v"(t2)); }
}

struct Args { const float* in[20]; float* out; unsigned char* ws; int ph_lo, ph_hi; };
typedef const __attribute__((address_space(4))) Args* KArgs;
struct Frame {
    LAS unsigned char* lds; int tid, lane, wave, vcu, G; KArgs ka;
    __device__ __forceinline__ const float* in(int i) const { return ka->in[i]; }
    __device__ __forceinline__ float* out() const { return ka->out; }
    __device__ __forceinline__ unsigned char* ws() const { return ka->ws; }
};
#define LDS_WAIT() asm volatile("s_waitcnt lgkmcnt(0)" ::: "memory")
__device__ __forceinline__ float wave_sum(float v) {
#pragma unroll
    for (int o = 1; o < 64; o <<= 1) v += __shfl_xor(v, o);
    return v;
}

__device__ __forceinline__ int colmap(int n, int cmode, int cpar) {
    if (cmode == 0) return n + cpar;
    if (cmode == 1) return ((n >> 4) & 1) * cpar + 128 * (n >> 8) + 32 * ((n >> 5) & 3) + 8 * ((n >> 2) & 3) + 4 * ((n >> 7) & 1) + (n & 3);
    if (cmode == 3) return (n & ~31) + 8 * ((n >> 2) & 3) + 4 * ((n >> 4) & 1) + (n & 3) + cpar;
    const int pn = n >> 8, bj = (n >> 7) & 1, wc = (n >> 5) & 3, i = n & 31;
    if (pn >= 8) return cpar * 3072 + 2048 + (4 * (pn & 3) + wc) * 64 + 32 * bj + 8 * ((n >> 2) & 3) + 4 * ((n >> 4) & 1) + (n & 3);
    return cpar * 3072 + (pn >> 2) * 1024 + (4 * (pn & 3) + wc) * 64 + 32 * bj + i;
}
__device__ __forceinline__ int fnet_freq(int p) { return p <= 63 ? p + 1 : (p == 64 ? 0 : p); }
struct TItem { const float* W; bf16_t* WT; const float* scale; int K, ldsrc, Nd, cmode, cpar, item, kperm; };
__device__ __forceinline__ void ti_load(const TItem& T, int lane, f32x4 (&v)[8]) {
    const int nblk = T.Nd / 32, kb = T.item / nblk, nb = T.item % nblk, k0 = 64 * kb, n0 = 32 * nb;
    const int c4 = lane & 7, kr = lane >> 3, scol = colmap(n0 + 4 * c4, T.cmode, T.cpar);
#pragma unroll
    for (int i = 0; i < 8; ++i) { const int kd = k0 + 8 * i + kr, ks_ = T.kperm ? (kd & ~127) + fnet_freq(kd & 127) : kd; v[i] = __builtin_nontemporal_load((const f32x4*)(T.W + (size_t)ks_ * T.ldsrc + scol)); }
}
__device__ __forceinline__ void ti_finish(const TItem& T, int lane, const f32x4 (&v)[8], LAS float* scr) {
    const int nblk = T.Nd / 32, kb = T.item / nblk, nb = T.item % nblk, k0 = 64 * kb, n0 = 32 * nb;
    const int c4 = lane & 7, kr = lane >> 3, c = lane & 7;
    f32x4 s0 = {1.f, 1.f, 1.f, 1.f}, s1 = s0;
    if (T.scale) { s0 = *(const f32x4*)(T.scale + k0 + 8 * c); s1 = *(const f32x4*)(T.scale + k0 + 8 * c + 4); }
#pragma unroll
    for (int i = 0; i < 8; ++i) { LAS float* d = scr + (8 * i + kr) * 33 + 4 * c4; d[0] = v[i][0]; d[1] = v[i][1]; d[2] = v[i][2]; d[3] = v[i][3]; }
    LDS_WAIT(); asm volatile("" ::: "memory");
#pragma unroll
    for (int j = 0; j < 4; ++j) { const int n = (lane >> 3) + 8 * j; const LAS float* s = scr + (8 * c) * 33 + n;
        u32x4 o; o.x = pk2(s[0 * 33] * s0[0], s[1 * 33] * s0[1]); o.y = pk2(s[2 * 33] * s0[2], s[3 * 33] * s0[3]); o.z = pk2(s[4 * 33] * s1[0], s[5 * 33] * s1[1]); o.w = pk2(s[6 * 33] * s1[2], s[7 * 33] * s1[3]);
        *(GAS u32x4*)(T.WT + (size_t)(n0 + n) * T.K + k0 + 8 * c) = o; }
    LDS_WAIT(); asm volatile("" ::: "memory");
}

__device__ __forceinline__ int t5_bucket(int rel) {
    const int n = rel < 0 ? -rel : rel; int bk;
    if (n < 8) bk = n; else if (n < 15) bk = 8; else if (n < 27) bk = 9; else if (n < 50) bk = 10; else if (n < 91) bk = 11; else if (n < 166) bk = 12; else if (n < 305) bk = 13; else if (n < 559) bk = 14; else bk = 15;
    return bk + (rel > 0 ? 16 : 0);
}

__device__ __forceinline__ void s5_prep_group(Frame& F, int g) {
    LAS float* apow = (LAS float*)F.lds;
    LAS float* bbar = apow + 2 * 17 * 64 * 2;
    LAS float* ccl = bbar + 2 * 64 * 16 * 2;
    LAS float* ktab = ccl + 2 * 16 * 64 * 2;
    const float* lre = F.in(4); const float* lim = F.in(5); const float* ldt = F.in(6); const float* bre = F.in(7); const float* bim = F.in(8); const float* cre = F.in(9); const float* cim = F.in(10);
    const int t = F.tid;
    if (t < 128) {
        const int d = t >> 6, n = t & 63, ix = (d * 64 + g) * 64 + n;
        const float lr = lre[ix], li = lim[ix], dt = expf(ldt[d * 64 + g]);
        float sn, cs; sincospif(li * dt * 0.3183098861837907f, &sn, &cs);
        const float em1 = expm1f(lr * dt), mag = em1 + 1.0f, ar = mag * cs, ai = mag * sn;
        float pr = 1.0f, pi = 0.0f;
        for (int tau = 0; tau <= 16; ++tau) { apow[((d * 17 + tau) * 64 + n) * 2] = pr; apow[((d * 17 + tau) * 64 + n) * 2 + 1] = pi; const float nr = pr * ar - pi * ai, ni = pr * ai + pi * ar; pr = nr; pi = ni; }
        ((float*)(F.ws() + WS_AL))[ix * 2] = apow[((d * 17 + 16) * 64 + n) * 2]; ((float*)(F.ws() + WS_AL))[ix * 2 + 1] = apow[((d * 17 + 16) * 64 + n) * 2 + 1];
        float sh, ch; sincospif(li * dt * 0.15915494309189535f, &sh, &ch);
        const float nr = em1 * cs - 2.0f * sh * sh, ni = ai;
        const float den = lr * lr + li * li;
        const float cr = (nr * lr + ni * li) / den, ci = (ni * lr - nr * li) / den;
        for (int q = 0; q < 16; ++q) { const float br = bre[(size_t)ix * 16 + q], bi = bim[(size_t)ix * 16 + q];
            bbar[((d * 64 + n) * 16 + q) * 2] = cr * br - ci * bi; bbar[((d * 64 + n) * 16 + q) * 2 + 1] = cr * bi + ci * br; }
    }
    for (int i = t; i < 2048; i += NTHREADS) { const int d = i >> 10, p = (i >> 6) & 15, n = i & 63; const size_t ix = ((size_t)(d * 64 + g) * 16 + p) * 64 + n; ccl[i * 2] = cre[ix]; ccl[i * 2 + 1] = cim[ix]; }
    __syncthreads();
    {
        const int d = t >> 8, p = (t >> 4) & 15, q = t & 15; float kacc[16];
#pragma unroll
        for (int tau = 0; tau < 16; ++tau) kacc[tau] = 0.f;
        for (int n = 0; n < 64; ++n) {
            const f32x2 c2 = *(const LAS f32x2*)(ccl + ((d * 16 + p) * 64 + n) * 2), b2 = *(const LAS f32x2*)(bbar + ((d * 64 + n) * 16 + q) * 2);
            const float er = c2[0] * b2[0] - c2[1] * b2[1], ei = c2[0] * b2[1] + c2[1] * b2[0];
#pragma unroll
            for (int tau = 0; tau < 16; ++tau) { const f32x2 a2 = *(const LAS f32x2*)(apow + ((d * 17 + tau) * 64 + n) * 2); kacc[tau] += er * a2[0] - ei * a2[1]; }
        }
#pragma unroll
        for (int tau = 0; tau < 16; ++tau) ktab[((d * 16 + tau) * 16 + p) * 16 + q] = kacc[tau];
    }
    __syncthreads();
    bf16_t* acat = (bf16_t*)(F.ws() + WS_ACAT) + (size_t)g * 256 * 512;
    for (int pc = t; pc < 256 * 64; pc += NTHREADS) {
        const int R = pc >> 6, c0 = (pc & 63) * 8, i = R >> 4, p = R & 15; float v[8];
        if (c0 < 256) { const int j = c0 >> 4, q0 = c0 & 15;
#pragma unroll
            for (int e = 0; e < 8; ++e) { float s = 0.f; if (j <= i) s += ktab[((0 * 16 + (i - j)) * 16 + p) * 16 + q0 + e]; if (j >= i) s += ktab[((1 * 16 + (j - i)) * 16 + p) * 16 + q0 + e]; v[e] = s; }
        } else { const int ci_ = c0 - 256, d = ci_ >> 7, part = (ci_ >> 6) & 1, n0 = ci_ & 63, tau = d == 0 ? i + 1 : 16 - i;
#pragma unroll
            for (int e = 0; e < 8; ++e) { const int n = n0 + e; const float cr = ccl[((d * 16 + p) * 64 + n) * 2], ci = ccl[((d * 16 + p) * 64 + n) * 2 + 1], ar = apow[((d * 17 + tau) * 64 + n) * 2], ai = apow[((d * 17 + tau) * 64 + n) * 2 + 1];
                v[e] = part == 0 ? (cr * ar - ci * ai) : -(cr * ai + ci * ar); }
        }
        u32x4 o; o.x = pk2(v[0], v[1]); o.y = pk2(v[2], v[3]); o.z = pk2(v[4], v[5]); o.w = pk2(v[6], v[7]);
        *(GAS u32x4*)(acat + (size_t)R * 512 + c0) = o;
    }
    bf16_t* bcat = (bf16_t*)(F.ws() + WS_BCAT) + (size_t)g * 256 * 256;
    for (int pc = t; pc < 256 * 32; pc += NTHREADS) {
        const int Rb = pc >> 5, c0 = (pc & 31) * 8, d = Rb >> 7, part = (Rb >> 6) & 1, n = Rb & 63, j = c0 >> 4, q0 = c0 & 15, tau = d == 0 ? 15 - j : j;
        const float ar = apow[((d * 17 + tau) * 64 + n) * 2], ai = apow[((d * 17 + tau) * 64 + n) * 2 + 1]; float v[8];
#pragma unroll
        for (int e = 0; e < 8; ++e) { const float br = bbar[((d * 64 + n) * 16 + q0 + e) * 2], bi = bbar[((d * 64 + n) * 16 + q0 + e) * 2 + 1]; v[e] = part == 0 ? (ar * br - ai * bi) : (ar * bi + ai * br); }
        u32x4 o; o.x = pk2(v[0], v[1]); o.y = pk2(v[2], v[3]); o.z = pk2(v[4], v[5]); o.w = pk2(v[6], v[7]);
        *(GAS u32x4*)(bcat + (size_t)Rb * 256 + c0) = o;
    }
    __syncthreads();
}

__device__ __forceinline__ void fh_item(Frame& F, int item) {
    const int ls = item >> 5, pn = (item >> 3) & 3, rg = item & 7, bj = rg >> 2, q = rg & 3, layer = ls == 0 ? 0 : 3, t = F.tid;
    bf16_t* dst = (bf16_t*)(F.ws() + WS_FH) + ((size_t)(ls * 4 + pn) * 256 + 32 * rg) * 256;
    const float* gn = F.in(1) + layer * DM + 256 * pn;
    for (int i = t; i < 32 * 256; i += NTHREADS) { const int r = i >> 8, kk = i & 255, part = r >> 4, ch = r & 15, m = kk & 127;
        float v = 0.f;
        if ((kk >> 7) == bj) {
            const bool special = (q == 3 && ch == 15); const int k = special ? (part ? 64 : 0) : 16 * q + 1 + ch;
            float sn, cs; sincospif((float)((k * m) & 127) * (1.0f / 64.0f), &sn, &cs);
            v = ((part && !special) ? sn : cs) * gn[kk] * 0.08838834764831845f; }
        dst[i] = (bf16_t)f2bf(v); }
}

__device__ __forceinline__ void dft_tables_item(Frame& F) {
    bf16_t* wa = (bf16_t*)(F.ws() + WS_WA); bf16_t* wb = (bf16_t*)(F.ws() + WS_WB); float* tw = (float*)(F.ws() + WS_TW);
    const int t = F.tid;
    for (int i = t; i < 64 * 64; i += NTHREADS) { const int r = i >> 6, k = i & 63, po = r >> 5, s1 = r & 31, pi = k >> 5, s1p = k & 31;
        float sn, cs; sincospif((float)((s1 * s1p) & 31) * (1.0f / 16.0f), &sn, &cs);
        const float v = po == 0 ? (pi == 0 ? cs : -sn) : (pi == 0 ? -sn : -cs); wa[i] = (bf16_t)f2bf(v); }
    for (int i = t; i < 64 * 128; i += NTHREADS) { const int s2 = i >> 7, k = i & 127, part = k >> 6, s2p = k & 63;
        float sn, cs; sincospif((float)((s2 * s2p) & 63) * (1.0f / 32.0f), &sn, &cs);
        wb[i] = (bf16_t)f2bf((part == 0 ? cs : sn) * 0.022097086912079608f); }
    for (int i = t; i < 32 * 64; i += NTHREADS) { const int s1 = i >> 6, s2p = i & 63; float sn, cs; sincospif((float)(s1 * s2p) * (1.0f / 1024.0f), &sn, &cs); tw[2 * i] = cs; tw[2 * i + 1] = sn; }
}

__device__ __forceinline__ TItem prep_item(Frame& F, int set, int it) {
    constexpr int I_UP = 16 * 176, I_DN = 44 * 32, I_QKV = 16 * 96, I_WO = 16 * 32, I_GLU = 16 * 64;
    const int l = set; int r = it; TItem T; T.kperm = 0;
    if (r < I_UP) { T.W = F.in(18) + (size_t)l * DM * 2 * DFF; T.K = DM; T.ldsrc = 2 * DFF; T.WT = (bf16_t*)(F.ws() + WS_WUP) + (size_t)l * 2 * DFF * DM; T.Nd = 2 * DFF; T.cmode = 1; T.cpar = DFF; T.scale = F.in(2) + l * DM; T.item = r; return T; } r -= I_UP;
    if (r < I_DN) { T.W = F.in(19) + (size_t)l * DFF * DM; T.K = DFF; T.ldsrc = DM; T.WT = (bf16_t*)(F.ws() + WS_WDN) + (size_t)l * DM * DFF; T.Nd = DM; T.cmode = 3; T.cpar = 0; T.scale = nullptr; T.item = r; return T; } r -= I_DN;
    if (set == 0 || set == 3) { const int js = set == 0 ? 0 : 1; T.W = F.in(3) + (size_t)js * DM * DM; T.K = DM; T.ldsrc = DM; T.WT = (bf16_t*)(F.ws() + WS_WOUT) + (size_t)js * DM * DM; T.Nd = DM; T.cmode = 3; T.cpar = 0; T.scale = nullptr; T.item = r; T.kperm = 1; return T; }
    if (set == 1) {
        if (r < I_GLU) { T.W = F.in(12); T.K = DM; T.ldsrc = 2 * DM; T.WT = (bf16_t*)(F.ws() + WS_WGLU); T.Nd = 2 * DM; T.cmode = 1; T.cpar = DM; T.scale = nullptr; T.item = r; return T; }
        T.W = F.in(16); T.K = DM; T.ldsrc = DM; T.WT = (bf16_t*)(F.ws() + WS_WO); T.Nd = DM; T.cmode = 3; T.cpar = 0; T.scale = nullptr; T.item = r - I_GLU; return T; }
    { const int g = r / I_QKV; T.W = F.in(13); T.K = DM; T.ldsrc = 9216; T.WT = (bf16_t*)(F.ws() + WS_WQK) + (size_t)g * 3072 * DM; T.Nd = 3072; T.cmode = 2; T.cpar = g; T.scale = F.in(1) + 2 * DM; T.item = r % I_QKV; return T; }
}
__device__ __forceinline__ void prep_transposes(Frame& F, int set, int gw, int NGW) {
    LAS float* scr = (LAS float*)(F.lds + F.wave * 16384);
    constexpr int I_UP = 16 * 176, I_DN = 44 * 32, I_QKV = 16 * 96, I_WO = 16 * 32, I_GLU = 16 * 64;
    const int nitems = I_UP + I_DN + (set == 1 ? I_GLU + I_WO : 0) + (set == 2 ? 3 * I_QKV : 0) + ((set == 0 || set == 3) ? I_WO : 0);
    if (gw >= nitems) return;
    TItem T = prep_item(F, set, gw); f32x4 v[8], vn[8];
    ti_load(T, F.lane, v);
    for (int it = gw; it < nitems; it += NGW) {
        const bool more = it + NGW < nitems; TItem Tn = T;
        if (more) { Tn = prep_item(F, set, it + NGW); ti_load(Tn, F.lane, vn); }
        ti_finish(T, F.lane, v, scr);
        if (more) { T = Tn;
#pragma unroll
            for (int i = 0; i < 8; ++i) v[i] = vn[i]; }
    }
}
__device__ __forceinline__ void prep_background(Frame& F, int L) {
    const int bb = (int)blockIdx.x - 128; if (bb < 0 || L > 2) return;
    if (L == 0) { if (bb < 64) s5_prep_group(F, bb); else prep_transposes(F, 1, (bb - 64) * NWAVES + F.wave, 64 * NWAVES); }
    else prep_transposes(F, L + 1, bb * NWAVES + F.wave, 128 * NWAVES);
    if (L == 2 && bb < 32) fh_item(F, 32 + bb);
}

__device__ __forceinline__ void phase_prep(Frame& F) {
    for (int it = F.vcu; it < 32 + 1; it += F.G) {
        if (it < 32) fh_item(F, it); else dft_tables_item(F);
    }
    __syncthreads();
    { const float* rb = F.in(17); float* bt = (float*)(F.ws() + WS_BTAB);
      for (int i = F.vcu * NTHREADS + F.tid; i < 48 * 192; i += F.G * NTHREADS) { const int gh = i / 192, rel = i % 192 - 96, g = gh >> 4, dil = g == 0 ? 1 : (g == 1 ? 4 : 16);
          float gq = 0.f, gk = 0.f; for (int d = 0; d < 64; ++d) { gq = fmaxf(gq, fabsf(F.in(14)[g * 64 + d])); gk = fmaxf(gk, fabsf(F.in(15)[g * 64 + d])); }
          const float cb = 8.0f * LOG2E * gq * gk;
          bt[i] = rel == -96 ? cb : ((rel >= -64 && rel <= 64) ? rb[t5_bucket(rel * dil) * 48 + gh] * LOG2E - cb : -1e30f); } }
    const int gw = F.vcu * NWAVES + F.wave, NGW = F.G * NWAVES;
    prep_transposes(F, 0, gw, NGW);
    { float* ss0 = (float*)(F.ws() + WS_SSP); bf16_t* xb = (bf16_t*)(F.ws() + WS_XB);
      for (int m0 = gw; m0 < MTOK; m0 += 4 * NGW) {
          f32x4 v[4][4];
#pragma unroll
          for (int r = 0; r < 4; ++r) { const GAS f32x4* xr = (const GAS f32x4*)(F.in(0) + (size_t)(m0 + r * NGW) * DM) + F.lane;
#pragma unroll
              for (int j = 0; j < 4; ++j) v[r][j] = __builtin_nontemporal_load(&xr[64 * j]); }
#pragma unroll
          for (int r = 0; r < 4; ++r) { const int m = m0 + r * NGW; float s = 0.f;
#pragma unroll
              for (int j = 0; j < 4; ++j) s += (v[r][j][0] * v[r][j][0] + v[r][j][1] * v[r][j][1]) + (v[r][j][2] * v[r][j][2] + v[r][j][3] * v[r][j][3]);
              s = wave_sum(s); if (F.lane < 16) ss0[(size_t)m * 32 + F.lane] = F.lane == 0 ? s : 0.f;
              GAS u32x2* o8 = (GAS u32x2*)(xb + (size_t)m * DM) + F.lane;
#pragma unroll
              for (int j = 0; j < 4; ++j) { u32x2 w; w.x = pk2(v[r][j][0], v[r][j][1]); w.y = pk2(v[r][j][2], v[r][j][3]); o8[64 * j] = w; } } } }
}

__device__ __forceinline__ void s5_gather(Frame& F, int pm) {
    const bf16_t* x = (const bf16_t*)(F.ws() + WS_XB); const float* ss = (const float*)(F.ws() + WS_SSP) + (size_t)2 * MTOK * 32; bf16_t* uc = (bf16_t*)(F.ws() + WS_UCAT);
    const int g = pm >> 2, t2 = 2 * (pm & 3);
    const float* gn = F.in(1) + 1 * DM + 16 * g;
    f32x4 gv[4];
#pragma unroll
    for (int j = 0; j < 4; ++j) gv[j] = *(const f32x4*)(gn + 4 * j);
    for (int i0 = 0; i0 < 8; i0 += 4) {
        u32x4 x0[4], x1[4]; float r[4];
#pragma unroll
        for (int i = 0; i < 4; ++i) { const int loc = F.tid + 512 * (i0 + i), tok = (t2 + (loc >> 11)) * 2048 + (loc & 2047);
            const u32x4* xp = (const u32x4*)(x + (size_t)tok * DM + 16 * g); x0[i] = xp[0]; x1[i] = xp[1]; r[i] = rstd_tok(ss, tok, 4); }
#pragma unroll
        for (int i = 0; i < 4; ++i) { const int loc = F.tid + 512 * (i0 + i), b = t2 + (loc >> 11), s = loc & 2047, c = s >> 4, jj = s & 15; f32x4 v[4];
            v[0] = (f32x4){bflo(x0[i].x), bfhi(x0[i].x), bflo(x0[i].y), bfhi(x0[i].y)} * gv[0] * r[i]; v[1] = (f32x4){bflo(x0[i].z), bfhi(x0[i].z), bflo(x0[i].w), bfhi(x0[i].w)} * gv[1] * r[i];
            v[2] = (f32x4){bflo(x1[i].x), bfhi(x1[i].x), bflo(x1[i].y), bfhi(x1[i].y)} * gv[2] * r[i]; v[3] = (f32x4){bflo(x1[i].z), bfhi(x1[i].z), bflo(x1[i].w), bfhi(x1[i].w)} * gv[3] * r[i];
            u32x4 o0, o1; o0.x = pk2(v[0][0], v[0][1]); o0.y = pk2(v[0][2], v[0][3]); o0.z = pk2(v[1][0], v[1][1]); o0.w = pk2(v[1][2], v[1][3]);
            o1.x = pk2(v[2][0], v[2][1]); o1.y = pk2(v[2][2], v[2][3]); o1.z = pk2(v[3][0], v[3][1]); o1.w = pk2(v[3][2], v[3][3]);
            bf16_t* dp = uc + ((size_t)(g * 1024 + b * 128 + c) * 512 + jj * 16);
            *(u32x4*)dp = o0; *(u32x4*)(dp + 8) = o1; }
    }
}
__device__ __forceinline__ void phase_s5scan(Frame& F, int pm) {
    if (F.wave >= 4) return;
    const int dir = F.wave & 1, b = 2 * (pm & 3) + (F.wave >> 1), g = pm >> 2, n = F.lane;
    const float* al = (const float*)(F.ws() + WS_AL) + ((size_t)(dir * 64 + g) * 64 + n) * 2; const float ar = al[0], ai = al[1];
    const float* sb = (const float*)(F.ws() + WS_SBUF) + (size_t)(g * 1024 + b * 128) * 256 + dir * 128 + n;
    bf16_t* uc = (bf16_t*)(F.ws() + WS_UCAT) + (size_t)(g * 1024 + b * 128) * 512 + 256 + dir * 128 + n;
    float hr = 0.f, hi = 0.f;
    for (int c8 = 0; c8 < 128; c8 += 8) {
        float sr[8], si[8];
#pragma unroll
        for (int k = 0; k < 8; ++k) { const int c = dir == 0 ? c8 + k : 127 - (c8 + k); sr[k] = sb[(size_t)c * 256]; si[k] = sb[(size_t)c * 256 + 64]; }
#pragma unroll
        for (int k = 0; k < 8; ++k) { const int c = dir == 0 ? c8 + k : 127 - (c8 + k);
            uc[(size_t)c * 512] = (bf16_t)f2bf(hr); uc[(size_t)c * 512 + 64] = (bf16_t)f2bf(hi);
            const float nr = ar * hr - ai * hi + sr[k], ni = ar * hi + ai * hr + si[k]; hr = nr; hi = ni; }
    }
}

typedef short v4i16_t __attribute__((ext_vector_type(4)));
__device__ __forceinline__ v4i16_t lds_tr(LAS unsigned char* p) { return __builtin_amdgcn_ds_read_tr16_b64_v4i16((LAS v4i16_t*)p); }
__device__ __forceinline__ void phase_fdft(Frame& F) {
    const int lane = F.lane, w = F.wave, c31 = lane & 31, h = lane >> 5, blk = (lane >> 4) & 1, q = (lane & 15) >> 2, p = lane & 3;
    const bf16_t* gt = (const bf16_t*)(F.ws() + WS_GT); bf16_t* rf = (bf16_t*)(F.ws() + WS_RF);
    const bf16_t* wa = (const bf16_t*)(F.ws() + WS_WA); const bf16_t* wb = (const bf16_t*)(F.ws() + WS_WB); const float* tw = (const float*)(F.ws() + WS_TW);
    LAS unsigned char* img = F.lds; LAS unsigned char* wbl = F.lds + LDS_WB_OFF;
    for (int i = F.tid; i < 64 * 16; i += NTHREADS) { const int r = i >> 4, ch = i & 15; *(LAS u32x4*)(wbl + r * LDS_WB_ROW + ch * 16) = *(const u32x4*)(wb + r * 128 + ch * 8); }
    {
        const int b = (int)blockIdx.x & 7, nblk = (int)blockIdx.x >> 3, it = b * 64 + nblk, jb = nblk >> 2, qs = nblk & 3;
        LAS bf16_t* stash = (LAS bf16_t*)(F.lds + LDSCTL_OFF + 4096);
        {
            const char* src = (const char*)(gt + (size_t)it * 65536) + lane * 16;
#pragma unroll
            for (int i = 0; i < 16; ++i) __builtin_amdgcn_global_load_lds((const unsigned*)(src + (w * 16 + i) * 1024), (LAS unsigned*)(img + (w * 16 + i) * 1024), 16, 0, 0);
            asm volatile("s_waitcnt vmcnt(0)" ::: "memory");
        }
        __syncthreads();
        {
            bf16x8 wf[2][4];
#pragma unroll
            for (int nt = 0; nt < 2; ++nt)
#pragma unroll
                for (int ks = 0; ks < 4; ++ks) wf[nt][ks] = *(const bf16x8*)(wa + (nt * 32 + c31) * 64 + 16 * ks + 8 * h);
            for (int cgi = 0; cgi < 4; ++cgi) {
                const int s2b = 2 * (w + 8 * cgi), s2r = s2b + blk;
                f32x16 acc[2] = {{}, {}};
#pragma unroll
                for (int ks = 0; ks < 4; ++ks) {
                    const int pi = ks >> 1, s1p0 = 16 * (ks & 1) + 8 * h + q;
                    LAS unsigned char* a0 = img + ((pi * 64 + s2r) * 32 + ((s1p0) ^ (blk << 2))) * 32 + 8 * p;
                    LAS unsigned char* a1 = img + ((pi * 64 + s2r) * 32 + ((s1p0 + 4) ^ (blk << 2))) * 32 + 8 * p;
                    const v4i16_t lo = lds_tr(a0), hi = lds_tr(a1);
                    const bf16x8 af = {lo[0], lo[1], lo[2], lo[3], hi[0], hi[1], hi[2], hi[3]};
#pragma unroll
                    for (int nt = 0; nt < 2; ++nt) acc[nt] = __builtin_amdgcn_mfma_f32_32x32x16_bf16(af, wf[nt][ks], acc[nt], 0, 0, 0);
                }
#pragma unroll
                for (int jj = 0; jj < 2; ++jj) {
                    const int s2 = s2b + jj; f32x2 cs; { float sn_, cs_; sincospif((float)(c31 * s2) * (1.0f / 1024.0f), &sn_, &cs_); cs[0] = cs_; cs[1] = sn_; }
#pragma unroll
                    for (int u2 = 0; u2 < 2; ++u2) {
                        const int tq = 2 * jj + u2, nq = 2 * u2 + h; float re[4], im[4];
#pragma unroll
                        for (int e = 0; e < 4; ++e) { const float tr = acc[0][4 * tq + e], ti = acc[1][4 * tq + e]; re[e] = tr * cs[0] + ti * cs[1]; im[e] = ti * cs[0] - tr * cs[1]; }
                        const int slot = (c31 ^ (((s2 & 3) * 4 + nq) * 2)) * 8;
                        u32x2 wr_, wi_; wr_.x = pk2(re[0], re[1]); wr_.y = pk2(re[2], re[3]); wi_.x = pk2(im[0], im[1]); wi_.y = pk2(im[2], im[3]);
                        *(LAS u32x2*)(img + ((0 * 64 + s2) * 4 + nq) * 256 + slot) = wr_;
                        *(LAS u32x2*)(img + ((1 * 64 + s2) * 4 + nq) * 256 + slot) = wi_;
                    }
                }
                asm volatile("s_waitcnt lgkmcnt(0)" ::: "memory");
            }
        }
        __syncthreads();
        {
            for (int sbi = 0; sbi < 2; ++sbi) {
                const int s1b = 2 * (w + 8 * sbi), s1r = s1b + blk;
                f32x16 acc[2] = {{}, {}}, aci[2] = {{}, {}};
#pragma unroll
                for (int ks = 0; ks < 8; ++ks) {
                    const int part = ks >> 2, s2p0 = 16 * (ks & 3) + 8 * h + q;
                    const int slot = (s1r ^ ((q * 4 + p) * 2)) * 8;
                    const v4i16_t lo = lds_tr(img + ((part * 64 + s2p0) * 4 + p) * 256 + slot), hi = lds_tr(img + ((part * 64 + s2p0 + 4) * 4 + p) * 256 + slot);
                    const bf16x8 af = {lo[0], lo[1], lo[2], lo[3], hi[0], hi[1], hi[2], hi[3]};
#pragma unroll
                    for (int nt = 0; nt < 2; ++nt) { const bf16x8 wfr = *(const LAS bf16x8*)(wbl + (nt * 32 + c31) * LDS_WB_ROW + 32 * ks + 16 * h);
                        acc[nt] = __builtin_amdgcn_mfma_f32_32x32x16_bf16(af, wfr, acc[nt], 0, 0, 0); }
                    if (qs == 3) {
#pragma unroll
                        for (int nt = 0; nt < 2; ++nt) { u32x4 wi = *(const LAS u32x4*)(wbl + (nt * 32 + c31) * LDS_WB_ROW + 32 * (ks ^ 4) + 16 * h);
                            if (part == 0) { wi.x ^= 0x80008000u; wi.y ^= 0x80008000u; wi.z ^= 0x80008000u; wi.w ^= 0x80008000u; }
                            aci[nt] = __builtin_amdgcn_mfma_f32_32x32x16_bf16(af, __builtin_bit_cast(bf16x8, wi), aci[nt], 0, 0, 0); }
                    }
                }
                asm volatile("" ::: "memory");
#pragma unroll
                for (int nt = 0; nt < 2; ++nt)
#pragma unroll
                    for (int x = 0; x < 2; ++x) {
                        const int s = s1b + x + 32 * (32 * nt + c31), tok = b * 2048 + s, tokm = b * 2048 + ((2048 - s) & 2047);
#pragma unroll
                        for (int u2 = 0; u2 < 2; ++u2) { const int tq = 2 * x + u2, nq = 2 * u2 + h;
                            u32x2 wv; wv.x = pk2(acc[nt][4 * tq + 0], acc[nt][4 * tq + 1]); wv.y = pk2(acc[nt][4 * tq + 2], acc[nt][4 * tq + 3]); *(u32x2*)(rf + (size_t)tok * DM + 128 * jb + 16 * qs + 4 * nq) = wv;
                            u32x2 wm; wm.x = pk2(acc[nt][4 * tq + 3], acc[nt][4 * tq + 2]); wm.y = pk2(acc[nt][4 * tq + 1], acc[nt][4 * tq + 0]); *(u32x2*)(rf + (size_t)tokm * DM + 128 * jb + 124 - 16 * qs - 4 * nq) = wm; }
                        if (qs == 3 && h == 1) { stash[s] = (bf16_t)f2bf(acc[nt][4 * (2 * x + 1) + 3]); stash[2048 + s] = (bf16_t)f2bf(aci[nt][4 * (2 * x + 1) + 3]); }
                    }
            }
        }
        if (qs == 3) {
            asm volatile("s_waitcnt vmcnt(0) lgkmcnt(0)" ::: "memory");
            __syncthreads();
            for (int s = F.tid; s < 2048; s += NTHREADS) { const int sm = (2048 - s) & 2047;
                const float ca = 0.5f * (bf2f(stash[s]) + bf2f(stash[sm])), cb = -0.5f * (bf2f(stash[2048 + s]) + bf2f(stash[2048 + sm]));
                bf16_t* o = rf + (size_t)(b * 2048 + s) * DM + 128 * jb; o[64] = (bf16_t)f2bf(ca); o[63] = (bf16_t)f2bf(cb); }
        }
        __syncthreads();
    }
}

constexpr int AT_KROW = 144, AT_VROW = 192, AT_KT = 0, AT_VT = 384 * AT_KROW, AT_TAB = AT_VT + 384 * AT_VROW;
__device__ __forceinline__ void phase_attn(Frame& F, int g) {
    const int dil = g == 0 ? 1 : (g == 1 ? 4 : 16), seg = 2048 / dil, lane = F.lane, q = lane & 31, h = lane >> 5, t = F.tid, w = F.wave;
    const bf16_t* Qc = (const bf16_t*)(F.ws() + WS_QC); const bf16_t* Kc = (const bf16_t*)(F.ws() + WS_KC); const bf16_t* Vc = (const bf16_t*)(F.ws() + WS_VC);
    bf16_t* oacc = (bf16_t*)(F.ws() + WS_OACC); float* lacc = (float*)(F.ws() + WS_LACC);
    LAS unsigned char* Kt = F.lds + AT_KT; LAS unsigned char* Vt = F.lds + AT_VT; LAS float* tab = (LAS float*)(F.lds + AT_TAB);
    const int vb = F.vcu, b = vb >> 5, hh = (vb >> 1) & 15, half = vb & 1;
    if (t < 192) tab[t] = ((const float*)(F.ws() + WS_BTAB))[(g * 16 + hh) * 192 + t];
    u32x4 kst[6], vst[6];
    const __amdgpu_buffer_rsrc_t krs = __builtin_amdgcn_make_buffer_rsrc((void*)(Kc + (size_t)b * 2048 * DM), 0, 2048 * 2048, 0x00020000);
    const __amdgpu_buffer_rsrc_t vrs = __builtin_amdgcn_make_buffer_rsrc((void*)(Vc + (size_t)b * 2048 * DM), 0, 2048 * 2048, 0x00020000);
    const int kvo = (t >> 3) * 2048 + hh * 128 + (t & 7) * 16;
    const int kls = (t >> 3) * AT_KROW + (t & 7) * 16, vls = (t >> 3) * AT_VROW + (t & 7) * 16;
#define AT_LOAD(cs_) do { _Pragma("unroll") for (int i = 0; i < 6; ++i) { \
        kst[i] = __builtin_bit_cast(u32x4, __builtin_amdgcn_raw_buffer_load_b128(krs, kvo, ((cs_) - 64 + 64 * i) * 2048, 0)); \
        vst[i] = __builtin_bit_cast(u32x4, __builtin_amdgcn_raw_buffer_load_b128(vrs, kvo, ((cs_) - 64 + 64 * i) * 2048, 0)); } } while (0)
#define AT_STORE() do { _Pragma("unroll") for (int i = 0; i < 6; ++i) { \
        *(LAS u32x4*)(Kt + kls + i * (64 * AT_KROW)) = kst[i]; *(LAS u32x4*)(Vt + vls + i * (64 * AT_VROW)) = vst[i]; } } while (0)
    AT_LOAD(half * 1024);
    bf16x8 qf[4], qn[4];
    { const bf16_t* qp = Qc + (size_t)(b * 2048 + half * 1024 + 32 * w + q) * DM + hh * 64 + 8 * h;
#pragma unroll
      for (int s = 0; s < 4; ++s) qf[s] = *(const bf16x8*)(qp + 16 * s); }
    AT_STORE();
    __syncthreads();
    for (int rd = 0; rd < 4; ++rd) {
        const int cs = half * 1024 + 256 * rd;
        if (rd < 3) AT_LOAD(cs + 256);
        const int vin0 = cs + 32 * w, r = vin0 / seg, m0 = vin0 & (seg - 1);
        const int tok = b * 2048 + (m0 + q) * dil + r;
        if (rd < 3) { const bf16_t* qp = Qc + (size_t)(b * 2048 + vin0 + 256 + q) * DM + hh * 64 + 8 * h;
#pragma unroll
            for (int s = 0; s < 4; ++s) qn[s] = *(const bf16x8*)(qp + 16 * s); }
        u32x2 old[2][4]; float lo = 0.f;
        if (g != 0) { lo = lacc[tok * 16 + hh];
#pragma unroll
            for (int db = 0; db < 2; ++db)
#pragma unroll
                for (int tq = 0; tq < 4; ++tq) old[db][tq] = *(const u32x2*)(oacc + (size_t)tok * DM + hh * 64 + 32 * db + 8 * tq + 4 * h); }
        f32x16 O[2] = {{}, {}}; float l = 0.f;
#pragma unroll
        for (int kb = 0; kb < 5; ++kb) {
            const int mk0 = m0 - 64 + 32 * kb; const bool valid = (mk0 >= 0) && (mk0 < seg);
            if (!valid) continue;
            const LAS unsigned char* kp = Kt + (32 * (w + kb) + q) * AT_KROW + 16 * h;
            f32x16 a = {};
#pragma unroll
            for (int s = 0; s < 4; ++s) { const bf16x8 kf = *(const LAS bf16x8*)(kp + 32 * s); a = __builtin_amdgcn_mfma_f32_32x32x16_bf16(kf, qf[s], a, 0, 0, 0); }
#pragma unroll
            for (int e = 0; e < 16; ++e) { const int key = (e & 3) + 8 * (e >> 2) + 4 * h; const float bias = tab[32 * kb - 64 + key - q + 96]; const float p = fast_exp2(a[e] + bias); a[e] = p; l += p; }
#pragma unroll
            for (int s2 = 0; s2 < 2; ++s2) {
                u32x4 pw; pw.x = pk2(a[8 * s2 + 0], a[8 * s2 + 1]); pw.y = pk2(a[8 * s2 + 2], a[8 * s2 + 3]); pw.z = pk2(a[8 * s2 + 4], a[8 * s2 + 5]); pw.w = pk2(a[8 * s2 + 6], a[8 * s2 + 7]);
                const bf16x8 pb = __builtin_bit_cast(bf16x8, pw);
#pragma unroll
                for (int db = 0; db < 2; ++db) {
                    LAS unsigned char* va = Vt + (32 * (w + kb) + 16 * s2 + 4 * h + ((lane & 15) >> 2)) * AT_VROW + (32 * db + 16 * ((lane >> 4) & 1) + 4 * (lane & 3)) * 2;
                    const v4i16_t lo = lds_tr(va), hi = lds_tr(va + 8 * AT_VROW);
                    const bf16x8 vf = {lo[0], lo[1], lo[2], lo[3], hi[0], hi[1], hi[2], hi[3]};
                    O[db] = __builtin_amdgcn_mfma_f32_32x32x16_bf16(vf, pb, O[db], 0, 0, 0);
                }
            }
            __builtin_amdgcn_sched_barrier(0);
        }
        l += __shfl_xor(l, 32);
        const float mx = tab[0];
        {
            const float inv = fast_rcp(l), lse = mx + __builtin_amdgcn_logf(l);
            float wo = 0.f, wn = 1.f, ln = lse;
            if (g != 0) { const float mm = fmaxf(lo, lse); ln = mm + __builtin_amdgcn_logf(fast_exp2(lo - mm) + fast_exp2(lse - mm)); wo = fast_exp2(lo - ln); wn = fast_exp2(lse - ln); }
            wn *= inv;
#pragma unroll
            for (int db = 0; db < 2; ++db)
#pragma unroll
                for (int tq = 0; tq < 4; ++tq) {
                    bf16_t* op = oacc + (size_t)tok * DM + hh * 64 + 32 * db + 8 * tq + 4 * h; float o[4];
#pragma unroll
                    for (int e = 0; e < 4; ++e) o[e] = O[db][4 * tq + e] * wn;
                    if (g != 0) { const u32x2 ow = old[db][tq]; o[0] += wo * bflo(ow.x); o[1] += wo * bfhi(ow.x); o[2] += wo * bflo(ow.y); o[3] += wo * bfhi(ow.y); }
                    u32x2 wv; wv.x = pk2(o[0], o[1]); wv.y = pk2(o[2], o[3]); *(u32x2*)op = wv;
                }
            if (h == 0) lacc[tok * 16 + hh] = ln;
        }
        __syncthreads();
        if (rd < 3) { AT_STORE(); __syncthreads();
#pragma unroll
            for (int s = 0; s < 4; ++s) qf[s] = qn[s]; }
    }
#undef AT_LOAD
#undef AT_STORE
}
#ifndef MK_ONE_LAUNCH
#define MK_ONE_LAUNCH 1
#endif
constexpr int NPHASES = 26;
enum PhaseKind { PK_PREP = 0, PK_G1, PK_G2, PK_UP, PK_DOWN, PK_S5PRE, PK_S5A, PK_S5SCAN, PK_S5C, PK_GLU, PK_QK, PK_ATT, PK_WO, PK_FC };
struct PhaseDesc { int kind, layer, g, nobar; };
__device__ __forceinline__ PhaseDesc phase_desc(int ph) {
    PhaseDesc d; d.g = 0; d.nobar = 0;
    if (ph == 0) { d.kind = PK_PREP; d.layer = 0; return d; }
    if (ph <= 5) { d.layer = 0; d.kind = ph == 1 ? PK_G1 : ph == 2 ? PK_G2 : ph == 3 ? PK_FC : ph == 4 ? PK_UP : PK_DOWN; return d; }
    if (ph <= 11) { d.layer = 1; d.kind = ph == 6 ? PK_S5A : ph == 7 ? PK_S5SCAN : ph == 8 ? PK_S5C : ph == 9 ? PK_GLU : ph == 10 ? PK_UP : PK_DOWN; d.nobar = (ph == 6 || ph == 7) ? 2 : 0; return d; }
    if (ph <= 20) { d.layer = 2; if (ph <= 17) { const int q = ph - 12; d.g = q >> 1; d.kind = (q & 1) ? PK_ATT : PK_QK; } else d.kind = ph == 18 ? PK_WO : ph == 19 ? PK_UP : PK_DOWN; return d; }
    d.layer = 3; d.kind = ph == 21 ? PK_G1 : ph == 22 ? PK_G2 : ph == 23 ? PK_FC : ph == 24 ? PK_UP : PK_DOWN; return d;
}

struct EpiAny {
    int pk, L, gg; LAS float* rl;
    __device__ __forceinline__ void pre(const pg8::StaticOrder& S) const {
        if (!(pk == PK_G1 || pk == PK_UP || pk == PK_QK)) return;
        KArgs ka = (KArgs)__builtin_amdgcn_kernarg_segment_ptr(); asm volatile("" : "+s"(ka));
        int t = threadIdx.x; asm volatile("" : "+v"(t));
        unsigned char* ws = ka->ws; const float* ssb = (const float*)(ws + WS_SSP);
        const float* ssq = pk == PK_G1 ? ssb + (size_t)(2 * L) * MTOK * 32 : pk == PK_UP ? ssb + (size_t)(2 * L + 1) * MTOK * 32 : ssb + (size_t)4 * MTOK * 32;
        const int ns4 = (pk == PK_UP && L == 1) ? 8 : 4, dil = gg == 0 ? 1 : (gg == 1 ? 4 : 16);
        pg8::Unit u;
        for (int i = 0; i < 8 && S.next(i, u); ++i) if (t < 256) {
            int tok;
            if (pk == PK_UP) tok = u.pm * 256 + t;
            else if (pk == PK_G1) tok = (u.pm >> 3) * 2048 + 64 * (t & 31) + (u.pm & 7) * 8 + (t >> 5);
            else tok = (u.pm >> 3) * 2048 + epi::tokmap((u.pm * 256 + t) & 2047, dil);
            rl[i * 256 + t] = rstd_tok(ssq, tok, ns4);
        }
    }
    __device__ __forceinline__ void operator()(epi::AccRef acc, const pg8::Unit& u, int ui, int wr, int wc, int fr, int fq) const {
        KArgs ka = (KArgs)__builtin_amdgcn_kernarg_segment_ptr(); asm volatile("" : "+s"(ka));
        unsigned char* ws = ka->ws; float* ssb = (float*)(ws + WS_SSP); bf16_t* xb = (bf16_t*)(ws + WS_XB);
        const int dil = gg == 0 ? 1 : (gg == 1 ? 4 : 16);
        switch (pk) {
        case PK_G1: { epi::FnetStore E{(bf16_t*)(ws + WS_GT), ssb + (size_t)(2 * L) * MTOK * 32, 4, rl}; E(acc, u, ui, wr, wc, fr, fq); } break;
        case PK_DOWN: { epi::Resid E{L == 3 ? ka->out : nullptr, xb, L < 3 ? ssb + (size_t)(2 * L + 2) * MTOK * 32 : nullptr, 0}; E(acc, u, ui, wr, wc, fr, fq); } break;
        case PK_GLU: { epi::Resid E{nullptr, xb, ssb + (size_t)3 * MTOK * 32, 1}; E(acc, u, ui, wr, wc, fr, fq); } break;
        case PK_WO: { epi::Resid E{nullptr, xb, ssb + (size_t)5 * MTOK * 32, 0}; E(acc, u, ui, wr, wc, fr, fq); } break;
        case PK_FC: { epi::Resid E{nullptr, xb, ssb + (size_t)(2 * L + 1) * MTOK * 32, 0}; E(acc, u, ui, wr, wc, fr, fq); } break;
        case PK_UP: {
            if (ui == 0 && L != 1) {
                unsigned* ctl = (unsigned*)(ws + WS_CTL);
                if (threadIdx.x == 0) XB_SPIN(xb_ld(ctl + CW_ADONE + 64 * L) < 256u, ctl + CW_BAR);
                __syncthreads();
            }
            epi::SwiGlu E{(bf16_t*)(ws + WS_HD), ssb + (size_t)(2 * L + 1) * MTOK * 32, L == 1 ? 8 : 4, rl}; E(acc, u, ui, wr, wc, fr, fq); } break;
        case PK_QK: { epi::QkNorm E{(bf16_t*)(ws + WS_QC), (bf16_t*)(ws + WS_KC), (bf16_t*)(ws + WS_VC), ssb + (size_t)4 * MTOK * 32, 4, ka->in[14] + gg * 64, ka->in[15] + gg * 64, dil, 0.125f * LOG2E, rl}; E(acc, u, ui, wr, wc, fr, fq); } break;
        case PK_S5A: { epi::StoreF32 E{(float*)(ws + WS_SBUF)}; E(acc, u, ui, wr, wc, fr, fq); } break;
        default: { epi::S5Out E{(bf16_t*)(ws + WS_YBUF), (const bf16_t*)(ws + WS_UCAT), ka->in[11]}; E(acc, u, ui, wr, wc, fr, fq); } break;
        }
    }
};

__global__ void __launch_bounds__(NTHREADS, 2) hybrid_fwd(Args args) {
    extern __shared__ __attribute__((aligned(16))) unsigned char lds_raw[];
    Frame F;
    F.lds = (LAS unsigned char*)lds_raw;
    F.tid = threadIdx.x; F.lane = F.tid & 63; F.wave = __builtin_amdgcn_readfirstlane(F.tid >> 6);
    F.G = gridDim.x; { const int bx = blockIdx.x; F.vcu = (F.G % 8 == 0) ? (bx % 8) * (F.G / 8) + bx / 8 : bx; }
    F.ka = (KArgs)__builtin_amdgcn_kernarg_segment_ptr();
    volatile LAS unsigned* MISC = (volatile LAS unsigned*)(F.lds + MISC_OFF);
    for (int u = F.tid; u < (LDS_BYTES - LDSCTL_OFF) / 4; u += NTHREADS) ((LAS unsigned*)(F.lds + LDSCTL_OFF))[u] = 0u;
    __syncthreads();
    unsigned* barw = (unsigned*)(F.ws() + WS_CTL) + CW_BAR;
    XcdBarrier bar; bar.bar = barw; bar.x = 0; bar.st = nullptr;
    const bool multi = (args.ph_hi - args.ph_lo) > 1;
    if (multi) bar = xcd_barrier_post(barw, MISC + 8);
    unsigned* gmap = (unsigned*)(F.ws() + WS_CTL) + CW_GMAP;
    if (multi && threadIdx.x == 0) (void)__hip_atomic_fetch_or(&gmap[64 * (blockIdx.x & 7)], 1u << bar.x, __ATOMIC_RELAXED, __HIP_MEMORY_SCOPE_AGENT);
    int grp_local = -1;

    int prev_kind = -1, prev_nobar = 0;
    for (int ph = args.ph_lo; ph < args.ph_hi; ++ph) {
        const PhaseDesc pd = phase_desc(ph);
        const int L = pd.layer;
        { KArgs k = (KArgs)__builtin_amdgcn_kernarg_segment_ptr(); asm volatile("" : "+s"(k)); F.ka = k; int t_ = threadIdx.x; asm volatile("" : "+v"(t_)); F.tid = t_; F.lane = t_ & 63; F.wave = __builtin_amdgcn_readfirstlane(t_ >> 6); }
        unsigned char* ws = F.ws();
        float* ssb = (float*)(ws + WS_SSP);
        bf16_t* xb = (bf16_t*)(ws + WS_XB);
        pg8::Geo g{}; EpiAny e; e.pk = pd.kind; e.L = L; e.gg = pd.g; bool is_gemm = true;
        g.rsA = g.rsB = DM * 2; g.hsA = g.hsB = 128 * DM * 2; g.tsA = g.tsB = (size_t)256 * DM * 2; g.K = DM;
        e.rl = (LAS float*)(F.lds + LDSCTL_OFF + 4096);
        switch (pd.kind) {
        case PK_G1:
            g.A = (const char*)xb; g.B = (const char*)(ws + WS_FH) + (size_t)(L == 0 ? 0 : 1) * 1024 * 256 * 2; g.nM = 64; g.nN = 4; g.modeA = 2; g.hsA = 4 * 2048;
            g.K = 256; g.kwA = 512; g.rsB = 512; g.hsB = 128 * 512; g.tsB = (size_t)256 * 512;
            break;
        case PK_FC:
            g.A = (const char*)(ws + WS_RF); g.B = (const char*)(ws + WS_WOUT) + (size_t)(L == 0 ? 0 : 1) * DM * DM * 2; g.nM = 64; g.nN = 4;
            break;
        case PK_UP:
            g.A = (const char*)xb; g.B = (const char*)(ws + WS_WUP) + (size_t)L * 2 * DFF * DM * 2; g.nM = 64; g.nN = 22;
            break;
        case PK_DOWN:
            g.A = (const char*)(ws + WS_HD); g.B = (const char*)(ws + WS_WDN) + (size_t)L * DM * DFF * 2; g.K = DFF; g.nM = 64; g.nN = 4;
            g.rsA = g.rsB = DFF * 2; g.hsA = g.hsB = 128 * DFF * 2; g.tsA = g.tsB = (size_t)256 * DFF * 2;
            break;
        case PK_S5A:
            g.A = (const char*)(ws + WS_UCAT); g.B = (const char*)(ws + WS_BCAT); g.K = 256; g.nM = 256; g.nN = 1;
            g.rsA = 1024; g.hsA = 128 * 1024; g.tsA = (size_t)256 * 1024; g.rsB = 512; g.hsB = 128 * 512; g.tsB = (size_t)256 * 512; g.bsel = 1;
            break;
        case PK_S5C:
            g.A = (const char*)(ws + WS_UCAT); g.B = (const char*)(ws + WS_ACAT); g.K = 512; g.nM = 256; g.nN = 1;
            g.rsA = 1024; g.hsA = 128 * 1024; g.tsA = (size_t)256 * 1024; g.rsB = 1024; g.hsB = 128 * 1024; g.tsB = (size_t)256 * 1024; g.bsel = 1;
            break;
        case PK_GLU:
            g.A = (const char*)(ws + WS_YBUF); g.B = (const char*)(ws + WS_WGLU); g.nM = 64; g.nN = 8;
            break;
        case PK_QK: {
            const int dil = pd.g == 0 ? 1 : (pd.g == 1 ? 4 : 16);
            g.A = (const char*)xb; g.B = (const char*)(ws + WS_WQK) + (size_t)pd.g * 3072 * DM * 2; g.nM = 64; g.nN = 12;
            g.modeA = 1; g.dil = dil; g.rsA = dil * 2048; g.hsA = dil == 16 ? 2048 : 128 * dil * 2048;
        } break;
        case PK_WO:
            g.A = (const char*)(ws + WS_OACC); g.B = (const char*)(ws + WS_WO); g.nM = 64; g.nN = 4;
            break;
        default: is_gemm = false; break;
        }
        pg8::StaticOrder S; S.init(g.nM, g.nN, F.G, (int)blockIdx.x);
        if (prev_nobar == 2) { asm volatile("s_waitcnt vmcnt(0)" ::: "memory"); __syncthreads(); }
        else if (prev_kind >= 0) {
            bool loc = prev_kind == PK_G1 || prev_kind == PK_G2 || prev_kind == PK_FC || prev_kind == PK_UP || prev_kind == PK_GLU || prev_kind == PK_QK || prev_kind == PK_ATT || prev_kind == PK_WO;
            if (loc && grp_local < 0) {
                unsigned ok = 1u;
#pragma unroll
                for (int j = 0; j < 8; ++j) { const unsigned m = xb_ld(&gmap[64 * j]); ok &= (m != 0u && (m & (m - 1u)) == 0u) ? 1u : 0u; }
                grp_local = __builtin_amdgcn_readfirstlane((int)ok);
            }
            const char* pf = nullptr; pg8::Unit u0;
            if (is_gemm && prev_kind != PK_PREP && prev_kind != PK_DOWN && S.next(0, u0)) pf = g.B + g.offB(u0);
            xcd_barrier(bar, loc && grp_local > 0, pf, g.rsB);
        }
        prev_kind = pd.kind; prev_nobar = pd.nobar;
        if (multi && threadIdx.x == 0 && (pd.kind == PK_FC || pd.kind == PK_WO)) (void)xb_add((unsigned*)(F.ws() + WS_CTL) + CW_ADONE + 64 * L, 1u);
        if (pd.kind == PK_S5A) { pg8::Unit u0; if (S.next(0, u0)) s5_gather(F, u0.pm); asm volatile("s_waitcnt vmcnt(0)" ::: "memory"); __syncthreads(); }
        if (is_gemm) {
            pg8::gemm_phase(F.lds, g, S, e);
            if (pd.kind == PK_UP) prep_background(F, L);
        }
#ifndef NO_PREP
        else if (pd.kind == PK_PREP) phase_prep(F);
#endif
#ifndef NO_S5X
        else if (pd.kind == PK_S5SCAN) { pg8::StaticOrder S; S.init(256, 1, F.G, (int)blockIdx.x); pg8::Unit u; if (S.next(0, u)) phase_s5scan(F, u.pm); }
#endif
#ifndef NO_ATTN
        else if (pd.kind == PK_ATT) phase_attn(F, pd.g);
#endif
        else if (pd.kind == PK_G2) phase_fdft(F);
        else {}
    }
}

extern "C" void kernel_launch(void* const* d_in, const int* in_sizes, int n_in, void* d_out, int out_size, void* d_ws, size_t ws_size, hipStream_t stream) {
    static int grid = 0;
    if (grid == 0) {
        if (n_in != 20 || in_sizes[0] != MTOK * DM || out_size != MTOK * DM || ws_size < WS_END) { fprintf(stderr, "kernel_launch: unexpected shapes / workspace (n_in %d, ws %zu)\n", n_in, ws_size); grid = -1; return; }
        int dev = 0, cus = 0, per_cu = 0;
        if (hipGetDevice(&dev) != hipSuccess || hipDeviceGetAttribute(&cus, hipDeviceAttributeMultiprocessorCount, dev) != hipSuccess) { grid = -1; return; }
        if (hipFuncSetAttribute((const void*)hybrid_fwd, hipFuncAttributeMaxDynamicSharedMemorySize, LDS_BYTES) != hipSuccess) { fprintf(stderr, "kernel_launch: hipFuncSetAttribute failed\n"); grid = -1; return; }
        if (hipOccupancyMaxActiveBlocksPerMultiprocessor(&per_cu, (const void*)hybrid_fwd, NTHREADS, LDS_BYTES) != hipSuccess || per_cu < 1) { fprintf(stderr, "kernel_launch: occupancy query reports %d\n", per_cu); }
        (void)hipGetLastError();
        if (cus < 256) { fprintf(stderr, "kernel_launch: built for 256 CUs with one resident workgroup each (got %d CUs); nothing launched\n", cus); grid = -1; return; }
        grid = 256;
    }
    if (grid < 0) return;
    (void)hipMemsetAsync((char*)d_ws + WS_CTL, 0, CTL_ZERO_BYTES, stream);
    Args a{};
    for (int i = 0; i < 20; ++i) a.in[i] = (const float*)d_in[i];
    a.out = (float*)d_out; a.ws = (unsigned char*)d_ws;
#if MK_ONE_LAUNCH
    a.ph_lo = 0; a.ph_hi = NPHASES;
    hipLaunchKernelGGL(hybrid_fwd, dim3(grid), dim3(NTHREADS), LDS_BYTES, stream, a);
#else
    for (int p = 0; p < NPHASES; ++p) { a.ph_lo = p; a.ph_hi = p + 1; hipLaunchKernelGGL(hybrid_fwd, dim3(grid), dim3(NTHREADS), LDS_BYTES, stream, a); }
#endif
}
```

```cpp
#include <hip/hip_runtime.h>
#include <cstdio>
#include <cstdint>

#define LAS __attribute__((address_space(3)))
#define GAS __attribute__((address_space(1)))
typedef unsigned short bf16_t;
typedef short bf16x8 __attribute__((ext_vector_type(8)));
typedef float f32x4 __attribute__((ext_vector_type(4)));
typedef float f32x2 __attribute__((ext_vector_type(2)));
typedef float f32x16 __attribute__((ext_vector_type(16)));
typedef unsigned u32x4 __attribute__((ext_vector_type(4)));
typedef unsigned u32x2 __attribute__((ext_vector_type(2)));
typedef GAS unsigned gu32;

constexpr int BATCH = 8, SEQ = 2048, DM = 1024, MTOK = BATCH * SEQ, DFF = 2816, DEPTH = 4;
constexpr float EPS = 1e-6f;
constexpr float LOG2E = 1.4426950408889634f;

__device__ __forceinline__ unsigned f2bf(float f) { unsigned u = __builtin_bit_cast(unsigned, f); return (u + 0x7fffu + ((u >> 16) & 1u)) >> 16; }
typedef __bf16 bf16x2_t __attribute__((ext_vector_type(2)));
__device__ __forceinline__ unsigned pk2(float lo, float hi) { const f32x2 v = {lo, hi}; return __builtin_bit_cast(unsigned, __builtin_convertvector(v, bf16x2_t)); }
__device__ __forceinline__ float bf2f(unsigned short h) { return __builtin_bit_cast(float, (unsigned)h << 16); }
__device__ __forceinline__ float bflo(unsigned w) { return __builtin_bit_cast(float, w << 16); }
__device__ __forceinline__ float bfhi(unsigned w) { return __builtin_bit_cast(float, w & 0xffff0000u); }
__device__ __forceinline__ float fast_rcp(float x) { return __builtin_amdgcn_rcpf(x); }
__device__ __forceinline__ float fast_exp2(float x) { return __builtin_amdgcn_exp2f(x); }
__device__ __forceinline__ float sigmoidf_(float x) { return fast_rcp(1.0f + fast_exp2(-LOG2E * x)); }
__device__ __forceinline__ float rstd_of(float ss) { return __builtin_amdgcn_rsqf(ss * (1.0f / DM) + EPS); }
template <int NS4> __device__ __forceinline__ float rstd_tok_u(const float* ssp, int tok) {
    const f32x4* p = (const f32x4*)(ssp + (size_t)tok * 32); f32x4 v[NS4];
#pragma unroll
    for (int i = 0; i < NS4; ++i) v[i] = p[i];
    float s = 0.f;
#pragma unroll
    for (int i = 0; i < NS4; ++i) s += (v[i][0] + v[i][1]) + (v[i][2] + v[i][3]);
    return rstd_of(s);
}
template <int NS4> __device__ __forceinline__ float rstd_tok_u64(const float* ssp, int tok) {
    const f32x4* p = (const f32x4*)(ssp + (size_t)tok * 64); f32x4 v[NS4];
#pragma unroll
    for (int i = 0; i < NS4; ++i) v[i] = p[i];
    float s = 0.f;
#pragma unroll
    for (int i = 0; i < NS4; ++i) s += (v[i][0] + v[i][1]) + (v[i][2] + v[i][3]);
    return rstd_of(s);
}
__device__ __forceinline__ float rstd_tok(const float* ssp, int tok, int ns4) { return ns4 == 16 ? rstd_tok_u64<16>(ssp, tok) : (ns4 == 8 ? rstd_tok_u<8>(ssp, tok) : rstd_tok_u<4>(ssp, tok)); }

namespace pg8 {
constexpr int BM = 256, BK = 64, HALF = 128, HTB = HALF * BK * 2  , STAGE_BYTES = 8 * HTB, NXCD = 8, WGM = 8;
__host__ __device__ __forceinline__ int lds_byte(int r, int c) { const int st = (r >> 4) * 2 + (c >> 5), rr = r & 15, cc = c & 31, ob = rr * 64 + cc * 2; return st * 1024 + (ob ^ (((ob >> 9) & 1) << 5)); }
__host__ __device__ __forceinline__ void stage_rc(int b, int& R, int& C) { const int st = b / 1024, sb = b % 1024, swz = sb ^ (((sb >> 9) & 1) << 5); R = (st >> 1) * 16 + swz / 64; C = (st & 1) * 32 + (swz % 64) / 2; }

struct Unit { int pm, pn; };
struct Geo {
    const char* A; const char* B; int K, nM, nN;
    unsigned rsA, rsB, hsA, hsB;
    size_t tsA, tsB;
    int modeA, modeB;
    int bsel;
    unsigned kwA;
    int dil;
    __device__ __forceinline__ size_t gather(int p) const {
        const int b = p >> 3, vin0 = (p & 7) * 256;
        const int tok0 = dil == 1 ? vin0 : (dil == 4 ? ((vin0 & 511) * 4 + (vin0 >> 9)) : (vin0 >> 7));
        return (size_t)(b * 2048 + tok0) * 2048u;
    }
    __device__ __forceinline__ size_t offA(const Unit& u) const { return (size_t)kwA * (unsigned)u.pn + (modeA == 2 ? (size_t)((u.pm >> 3) * 2048 + (u.pm & 7) * 8) * 2048u : (modeA ? gather(u.pm) : (size_t)u.pm * tsA)); }
    __device__ __forceinline__ size_t offB(const Unit& u) const { const int i = bsel ? (u.pm >> 2) : u.pn; return modeB ? gather(i) : (size_t)i * tsB; }
};
struct StaticOrder {
    int nM, nN, nwg, G, c;
    __device__ void init(int nM_, int nN_, int G_, int c_) { nM = nM_; nN = nN_; nwg = nM * nN; G = G_; c = c_; }
    __device__ bool next(int i, Unit& u) const {
        const long L = (long)i * G + c; if (L >= nwg) return false;
        int wgid = (int)L; { const int q = nwg / NXCD, r = nwg % NXCD, xcd = wgid % NXCD, off = wgid / NXCD; wgid = (xcd < r ? xcd * (q + 1) : r * (q + 1) + (xcd - r) * q) + off; }
        const int nig = WGM * nN, gid = wgid / nig, fm = gid * WGM, gsz = (nM - fm) < WGM ? (nM - fm) : WGM;
        u.pm = fm + ((wgid % nig) % gsz); u.pn = (wgid % nig) / gsz; return true;
    }
};

template <class Epi>
__device__ __forceinline__ void gemm_phase(LAS unsigned char* lds, const Geo g, const StaticOrder& S, const Epi& E) {
    int tid_ = threadIdx.x; asm volatile("" : "+v"(tid_));
    const int tid = tid_, wid = __builtin_amdgcn_readfirstlane(tid >> 6), lane = tid & 63, wr = wid >> 2, wc = wid & 3, fr = lane & 15, fq = lane >> 4;
    const int K = g.K, nt = K / BK;
    unsigned voffA[2], voffB[2];
#pragma unroll
    for (int i = 0; i < 2; ++i) { int R, C; stage_rc(tid * 16 + i * 8192, R, C); voffA[i] = (g.modeA == 2 ? (unsigned)((R & 31) * 64 + (R >> 5)) * 2048u : (unsigned)R * g.rsA) + (unsigned)C * 2u; voffB[i] = (unsigned)R * g.rsB + (unsigned)C * 2u; }
    const unsigned kstep = (unsigned)(BK * 2);
    const unsigned hstepA = g.hsA, hstepB = g.hsB;
    const __amdgpu_buffer_rsrc_t rsrcA = __builtin_amdgcn_make_buffer_rsrc((void*)g.A, 0, 0x7fffffff, 0x00020000);
    const __amdgpu_buffer_rsrc_t rsrcB = __builtin_amdgcn_make_buffer_rsrc((void*)g.B, 0, 0x7fffffff, 0x00020000);
    const unsigned ldsw = (unsigned)wid * 1024u;
    const int aoff = lds_byte(wr * 64 + fr, fq * 8), boff = lds_byte(wc * 32 + fr, fq * 8);
#define PG8_SA(b, h) (((b) * 2 + (h)) * HTB)
#define PG8_SB(b, h) ((4 + (b) * 2 + (h)) * HTB)
#define PG8_STAGE(bufoff, rs_soff, voff) PG8_STAGE_(bufoff, rs_soff, voff)
#define PG8_STAGE_(bufoff, rs, soff, voff) do { _Pragma("unroll") for (int _i = 0; _i < 2; ++_i) \
        __builtin_amdgcn_raw_ptr_buffer_load_lds(rs, (LAS unsigned*)(lds + (bufoff) + ldsw + _i * 8192), 16, (int)(voff)[_i], (int)(soff), 0, 0); } while (0)
#define PG8_LDA(dst, b, h) do { _Pragma("unroll") for (int m = 0; m < 4; ++m) _Pragma("unroll") for (int k = 0; k < 2; ++k) dst[m][k] = *(const LAS bf16x8*)(lds + PG8_SA(b, h) + aoff + m * 2048 + k * 1024); } while (0)
#define PG8_LDB(dst, b, h) do { _Pragma("unroll") for (int n = 0; n < 2; ++n) _Pragma("unroll") for (int k = 0; k < 2; ++k) dst[n][k] = *(const LAS bf16x8*)(lds + PG8_SB(b, h) + boff + n * 2048 + k * 1024); } while (0)
#define PG8_MMA(ai, bj, At, Bt) do { __builtin_amdgcn_s_setprio(1); _Pragma("unroll") for (int m = 0; m < 4; ++m) _Pragma("unroll") for (int n = 0; n < 2; ++n) _Pragma("unroll") for (int k = 0; k < 2; ++k) \
        acc[ai][bj][m][n] = __builtin_amdgcn_mfma_f32_16x16x32_bf16(Bt[n][k], At[m][k], acc[ai][bj][m][n], 0, 0, 0); __builtin_amdgcn_s_setprio(0); } while (0)
#define PG8_WAIT_V(n) asm volatile("s_waitcnt vmcnt(" #n ")" ::: "memory")
#define PG8_WAIT_L(n) asm volatile("s_waitcnt lgkmcnt(" #n ")" ::: "memory")
#define PG8_BAR __builtin_amdgcn_s_barrier()
#define PG8_SCHED __builtin_amdgcn_sched_barrier(0)
    Unit cur, nxt; int ui = 0;
    if (!S.next(0, cur)) return;
    f32x4 acc[2][2][4][2];
#pragma unroll
    for (int a = 0; a < 2; ++a)
#pragma unroll
        for (int b = 0; b < 2; ++b)
#pragma unroll
            for (int m = 0; m < 4; ++m)
#pragma unroll
                for (int n = 0; n < 2; ++n) acc[a][b][m][n] = (f32x4){0.f, 0.f, 0.f, 0.f};
    bf16x8 At[4][2], B0[2][2], B1[2][2];
    unsigned cA = (unsigned)g.offA(cur), cB = (unsigned)g.offB(cur);
    PG8_STAGE_(PG8_SB(0, 0), rsrcB, cB, voffB); PG8_STAGE_(PG8_SB(0, 1), rsrcB, cB + hstepB, voffB); PG8_STAGE_(PG8_SA(0, 0), rsrcA, cA, voffA); PG8_STAGE_(PG8_SA(0, 1), rsrcA, cA + hstepA, voffA);
    E.pre(S);
    if (wr == 1) PG8_BAR;
    PG8_WAIT_V(2); PG8_BAR;
    PG8_STAGE_(PG8_SB(1, 0), rsrcB, cB + kstep, voffB); PG8_STAGE_(PG8_SA(1, 0), rsrcA, cA + kstep, voffA); PG8_STAGE_(PG8_SB(1, 1), rsrcB, cB + hstepB + kstep, voffB);
    PG8_WAIT_V(6); PG8_BAR;
    for (;;) {
        const bool has_next = S.next(ui + 1, nxt);
        const unsigned nA = has_next ? (unsigned)g.offA(nxt) : cA, nB = has_next ? (unsigned)g.offB(nxt) : cB;
        for (int t = 0; t < nt; t += 2) {
            const bool last = (t == nt - 2);
            const unsigned a1 = cA + (unsigned)(t + 1) * kstep;
            const unsigned a2 = last ? nA : cA + (unsigned)(t + 2) * kstep, b2 = last ? nB : cB + (unsigned)(t + 2) * kstep;
            const unsigned a3 = a2 + kstep, b3 = b2 + kstep;
            PG8_LDB(B0, 0, 0); PG8_LDB(B1, 0, 1); PG8_SCHED; PG8_LDA(At, 0, 0); PG8_STAGE_(PG8_SA(1, 1), rsrcA, a1 + hstepA, voffA);
            PG8_WAIT_V(8); PG8_WAIT_L(0); PG8_BAR; PG8_MMA(0, 0, At, B0); PG8_MMA(0, 1, At, B1); PG8_BAR; PG8_SCHED;
            PG8_LDA(At, 0, 1); PG8_STAGE_(PG8_SB(0, 0), rsrcB, b2, voffB); PG8_STAGE_(PG8_SB(0, 1), rsrcB, b2 + hstepB, voffB); PG8_STAGE_(PG8_SA(0, 0), rsrcA, a2, voffA);
            PG8_WAIT_V(8); PG8_WAIT_L(0); PG8_BAR; PG8_MMA(1, 0, At, B0); PG8_MMA(1, 1, At, B1); PG8_BAR; PG8_SCHED;
            PG8_LDB(B0, 1, 0); PG8_LDB(B1, 1, 1); PG8_SCHED; PG8_LDA(At, 1, 0); PG8_STAGE_(PG8_SA(0, 1), rsrcA, a2 + hstepA, voffA);
            PG8_WAIT_V(8); PG8_WAIT_L(0); PG8_BAR; PG8_MMA(0, 0, At, B0); PG8_MMA(0, 1, At, B1); PG8_BAR; PG8_SCHED;
            PG8_LDA(At, 1, 1); PG8_STAGE_(PG8_SB(1, 0), rsrcB, b3, voffB); PG8_STAGE_(PG8_SB(1, 1), rsrcB, b3 + hstepB, voffB); PG8_STAGE_(PG8_SA(1, 0), rsrcA, a3, voffA);
            PG8_WAIT_V(8); PG8_WAIT_L(0); PG8_BAR; PG8_MMA(1, 0, At, B0); PG8_MMA(1, 1, At, B1); PG8_BAR; PG8_SCHED;
        }
        if (wr == 0) PG8_BAR;
        E(acc, cur, ui, wr, wc, fr, fq);
        if (!has_next) break;
#pragma unroll
        for (int a = 0; a < 2; ++a)
#pragma unroll
            for (int b = 0; b < 2; ++b)
#pragma unroll
                for (int m = 0; m < 4; ++m)
#pragma unroll
                    for (int n = 0; n < 2; ++n) acc[a][b][m][n] = (f32x4){0.f, 0.f, 0.f, 0.f};
        cur = nxt; cA = nA; cB = nB; ++ui;
        if (wr == 1) PG8_BAR;
    }
    PG8_WAIT_V(0);
    PG8_BAR;
#undef PG8_SA
#undef PG8_SB
#undef PG8_STAGE
#undef PG8_LDA
#undef PG8_LDB
#undef PG8_MMA
#undef PG8_WAIT_V
#undef PG8_WAIT_L
#undef PG8_BAR
#undef PG8_SCHED
}
}
namespace epi {
using pg8::Unit;
typedef const f32x4 (&AccRef)[2][2][4][2];

__device__ __forceinline__ int tokmap(int vin, int dil) {
    return dil == 1 ? vin : (dil == 4 ? ((vin & 511) * 4 + (vin >> 9)) : ((vin & 127) * 16 + (vin >> 7)));
}

struct ColScale {
    bf16_t* out; const float* ss; int ns4, mode, dil; LAS float* rl;
    __device__ __forceinline__ void operator()(AccRef acc, const Unit& u, int ui, int wr, int wc, int fr_, int fq_) const {
        int fr = fr_, fq = fq_; asm volatile("" : "+v"(fr), "+v"(fq));
        const int b = u.pn >> 3, cin0 = (u.pn & 7) * 256;
        f32x4 sc[2][2];
#pragma unroll
        for (int bj = 0; bj < 2; ++bj)
#pragma unroll
            for (int n = 0; n < 2; ++n) sc[bj][n] = *(const LAS f32x4*)(rl + ui * 256 + bj * 128 + wc * 32 + n * 16 + 4 * fq);
#pragma unroll
        for (int ai = 0; ai < 2; ++ai)
#pragma unroll
            for (int m = 0; m < 4; ++m) {
                const int row = u.pm * 256 + ai * 128 + wr * 64 + m * 16 + fr;
                bf16_t* rp;
                if (mode == 0) rp = out + ((size_t)(b * 1024 + (row & 1023)) * 4096 + (row >> 10) * 2048);
                else rp = out + (size_t)(b * 1024 + row) * 2048;
#pragma unroll
                for (int bj = 0; bj < 2; ++bj)
#pragma unroll
                    for (int n = 0; n < 2; ++n) {
                        const int cb = cin0 + wc * 32 + bj * 128 + n * 16;
                        const int c = mode == 0 ? cb + 4 * fq : cb + 8 * (fq & 1) + 4 * (fq >> 1);
                        const f32x4 v = acc[ai][bj][m][n] * sc[bj][n];
                        u32x2 w; w.x = pk2(v[0], v[1]); w.y = pk2(v[2], v[3]);
                        *(u32x2*)(rp + c) = w;
                    }
            }
    }
};

struct FnetStore {
    bf16_t* gt; const float* ss; int ns4; LAS float* rl;
    __device__ __forceinline__ void operator()(AccRef acc, const Unit& u, int ui, int wr, int wc, int fr_, int fq_) const {
        int fr = fr_, fq = fq_; asm volatile("" : "+v"(fr), "+v"(fq));
        const int b = u.pm >> 3, tb = (u.pm & 7) * 8;
#pragma unroll
        for (int ai = 0; ai < 2; ++ai)
#pragma unroll
            for (int m = 0; m < 4; ++m) {
                const int rl_ = ai * 128 + wr * 64 + m * 16 + fr, s2 = tb + (rl_ >> 5), cell = (rl_ & 31) ^ ((s2 & 1) << 2); const float r = rl[ui * 256 + rl_];
#pragma unroll
                for (int bj = 0; bj < 2; ++bj)
#pragma unroll
                    for (int n = 0; n < 2; ++n) {
                        const int nblk = 8 * u.pn + 4 * bj + wc;
                        const f32x4 v = acc[ai][bj][m][n] * r; u32x2 w; w.x = pk2(v[0], v[1]); w.y = pk2(v[2], v[3]);
                        *(u32x2*)(gt + ((((size_t)(b * 64 + nblk) * 2 + n) * 64 + s2) * 32 + cell) * 16 + 4 * fq) = w;
                    }
            }
    }
};

struct Resid {
    float* xout; bf16_t* xb; float* ssn; int glu;
    __device__ __forceinline__ void operator()(AccRef acc, const Unit& u, int ui, int wr, int wc, int fr_, int fq_) const {
        int fr = fr_, fq = fq_; asm volatile("" : "+v"(fr), "+v"(fq));
        const int row0 = u.pm * 256 + wr * 64 + fr;
#pragma unroll
        for (int ai = 0; ai < 2; ++ai) {
            u32x4 bs[4][2];
#pragma unroll
            for (int m = 0; m < 4; ++m) { const size_t ro = (size_t)(row0 + ai * 128 + m * 16) * DM;
                if (glu) { bs[m][0] = *(const u32x4*)(xb + ro + 128 * u.pn + 32 * wc + 8 * fq); bs[m][1] = (u32x4){0u, 0u, 0u, 0u}; }
                else {
#pragma unroll
                    for (int bj = 0; bj < 2; ++bj) bs[m][bj] = *(const u32x4*)(xb + ro + u.pn * 256 + bj * 128 + wc * 32 + 8 * fq); } }
            asm volatile("" ::: "memory");
#pragma unroll
            for (int m = 0; m < 4; ++m) {
                const int tok = row0 + ai * 128 + m * 16; const size_t ro = (size_t)tok * DM; float s2 = 0.f;
                if (glu) {
                    const int j = 128 * u.pn + 32 * wc + 8 * fq; const u32x4 b4 = bs[m][0]; float o[8];
                    const float bv[8] = {bflo(b4.x), bfhi(b4.x), bflo(b4.y), bfhi(b4.y), bflo(b4.z), bfhi(b4.z), bflo(b4.w), bfhi(b4.w)};
#pragma unroll
                    for (int bj = 0; bj < 2; ++bj)
#pragma unroll
                        for (int e = 0; e < 4; ++e) { const float v = bv[4 * bj + e] + acc[ai][bj][m][0][e] * sigmoidf_(acc[ai][bj][m][1][e]); o[4 * bj + e] = v; s2 += v * v; }
                    if (xout) { *(f32x4*)(xout + ro + j) = (f32x4){o[0], o[1], o[2], o[3]}; *(f32x4*)(xout + ro + j + 4) = (f32x4){o[4], o[5], o[6], o[7]}; }
                    else { u32x4 w; w.x = pk2(o[0], o[1]); w.y = pk2(o[2], o[3]); w.z = pk2(o[4], o[5]); w.w = pk2(o[6], o[7]); *(u32x4*)(xb + ro + j) = w; }
                } else {
#pragma unroll
                    for (int bj = 0; bj < 2; ++bj) {
                        const int c = u.pn * 256 + bj * 128 + wc * 32 + 8 * fq; const u32x4 b4 = bs[m][bj];
                        const f32x4 o0 = (f32x4){bflo(b4.x), bfhi(b4.x), bflo(b4.y), bfhi(b4.y)} + acc[ai][bj][m][0], o1 = (f32x4){bflo(b4.z), bfhi(b4.z), bflo(b4.w), bfhi(b4.w)} + acc[ai][bj][m][1];
                        s2 += ((o0[0] * o0[0] + o0[1] * o0[1]) + (o0[2] * o0[2] + o0[3] * o0[3])) + ((o1[0] * o1[0] + o1[1] * o1[1]) + (o1[2] * o1[2] + o1[3] * o1[3]));
                        if (xout) { __builtin_nontemporal_store(o0, (f32x4*)(xout + ro + c)); __builtin_nontemporal_store(o1, (f32x4*)(xout + ro + c + 4)); }
                        else { u32x4 w; w.x = pk2(o0[0], o0[1]); w.y = pk2(o0[2], o0[3]); w.z = pk2(o1[0], o1[1]); w.w = pk2(o1[2], o1[3]); *(u32x4*)(xb + ro + c) = w; }
                    }
                }
                s2 += __shfl_xor(s2, 16); s2 += __shfl_xor(s2, 32);
                if (fq == 0 && ssn) ssn[(size_t)tok * 32 + u.pn * 4 + wc] = s2;
            }
        }
    }
};

struct SwiGlu {
    bf16_t* hd; const float* ss; int ns4; LAS float* rl;
    __device__ __forceinline__ void operator()(AccRef acc, const Unit& u, int ui, int wr, int wc, int fr_, int fq_) const {
        int fr = fr_, fq = fq_; asm volatile("" : "+v"(fr), "+v"(fq));
#pragma unroll
        for (int ai = 0; ai < 2; ++ai)
#pragma unroll
            for (int m = 0; m < 4; ++m) {
                const int rl_ = ai * 128 + wr * 64 + m * 16 + fr, tok = u.pm * 256 + rl_; const float r = rl[ui * 256 + rl_]; float h[8];
#pragma unroll
                for (int bj = 0; bj < 2; ++bj) {
                    const f32x4 ga = acc[ai][bj][m][0], ua = acc[ai][bj][m][1];
#pragma unroll
                    for (int e = 0; e < 4; ++e) { const float gg = r * ga[e]; h[4 * bj + e] = gg * sigmoidf_(gg) * (r * ua[e]); }
                }
                u32x4 w; w.x = pk2(h[0], h[1]); w.y = pk2(h[2], h[3]); w.z = pk2(h[4], h[5]); w.w = pk2(h[6], h[7]);
                *(u32x4*)(hd + (size_t)tok * DFF + 128 * u.pn + 32 * wc + 8 * fq) = w;
            }
    }
};

struct QkNorm {
    bf16_t* qc; bf16_t* kc; bf16_t* vc; const float* ss; int ns4; const float* qgain; const float* kgain; int dil; float qscale; LAS float* rl;
    __device__ __forceinline__ void operator()(AccRef acc, const Unit& u, int ui, int wr, int wc, int fr_, int fq_) const {
        int fr = fr_, fq = fq_; asm volatile("" : "+v"(fr), "+v"(fq));
        const int which = u.pn >> 2, hh = 4 * (u.pn & 3) + wc;
        if (which == 2) {
#pragma unroll
            for (int ai = 0; ai < 2; ++ai)
#pragma unroll
                for (int m = 0; m < 4; ++m) { const int rl_ = ai * 128 + wr * 64 + m * 16 + fr; const float r = rl[ui * 256 + rl_];
#pragma unroll
                    for (int bj = 0; bj < 2; ++bj) { const f32x4 a0 = acc[ai][bj][m][0] * r, a1 = acc[ai][bj][m][1] * r;
                        u32x4 w; w.x = pk2(a0[0], a0[1]); w.y = pk2(a0[2], a0[3]); w.z = pk2(a1[0], a1[1]); w.w = pk2(a1[2], a1[3]);
                        *(u32x4*)(vc + (size_t)(u.pm * 256 + rl_) * DM + hh * 64 + 32 * bj + 8 * fq) = w; } }
            return;
        }
        const float* gp = which ? kgain : qgain; const float osc = which ? 1.0f : qscale;
        bf16_t* ob = (which ? kc : qc) + hh * 64;
        f32x4 gn[2][2];
#pragma unroll
        for (int bj = 0; bj < 2; ++bj)
#pragma unroll
            for (int n = 0; n < 2; ++n) gn[bj][n] = *(const f32x4*)(gp + 32 * bj + 16 * n + 4 * fq) * osc;
        const int b = u.pm >> 3;
#pragma unroll
        for (int ai = 0; ai < 2; ++ai)
#pragma unroll
            for (int m = 0; m < 4; ++m) {
                const int rl_ = ai * 128 + wr * 64 + m * 16 + fr; const int v = u.pm * 256 + rl_;
                const float r = rl[ui * 256 + rl_]; float s2 = 0.f;
#pragma unroll
                for (int bj = 0; bj < 2; ++bj)
#pragma unroll
                    for (int n = 0; n < 2; ++n) { const f32x4 a = acc[ai][bj][m][n]; s2 += (a[0] * a[0] + a[1] * a[1]) + (a[2] * a[2] + a[3] * a[3]); }
                s2 += __shfl_xor(s2, 16); s2 += __shfl_xor(s2, 32);
                const float f = r * __builtin_amdgcn_rsqf(r * r * s2 * (1.0f / 64.0f) + EPS);
#pragma unroll
                for (int bj = 0; bj < 2; ++bj) { const f32x4 a0 = acc[ai][bj][m][0] * f * gn[bj][0], a1 = acc[ai][bj][m][1] * f * gn[bj][1];
                    u32x4 w; w.x = pk2(a0[0], a0[1]); w.y = pk2(a0[2], a0[3]); w.z = pk2(a1[0], a1[1]); w.w = pk2(a1[2], a1[3]); *(u32x4*)(ob + (size_t)v * DM + 16 * fq + 8 * bj) = w; }
            }
    }
};

struct StoreF32 {
    float* C;
    __device__ __forceinline__ void operator()(AccRef acc, const Unit& u, int ui, int wr, int wc, int fr_, int fq_) const {
        int fr = fr_, fq = fq_; asm volatile("" : "+v"(fr), "+v"(fq));
#pragma unroll
        for (int ai = 0; ai < 2; ++ai)
#pragma unroll
            for (int m = 0; m < 4; ++m) { float* rp = C + (size_t)(u.pm * 256 + ai * 128 + wr * 64 + m * 16 + fr) * 256 + wc * 32 + 4 * fq;
#pragma unroll
                for (int bj = 0; bj < 2; ++bj)
#pragma unroll
                    for (int n = 0; n < 2; ++n) *(f32x4*)(rp + bj * 128 + n * 16) = acc[ai][bj][m][n]; }
    }
};

constexpr int S5_LDS_ROW = 520;
struct StoreS5Lds {
    LAS unsigned char* lds;
    __device__ __forceinline__ void operator()(AccRef acc, const Unit& u, int ui, int wr, int wc, int fr_, int fq_) const {
        int fr = fr_, fq = fq_; asm volatile("" : "+v"(fr), "+v"(fq));
        asm volatile("s_waitcnt vmcnt(0)" ::: "memory"); __syncthreads();
#pragma unroll
        for (int ai = 0; ai < 2; ++ai)
#pragma unroll
            for (int m = 0; m < 4; ++m) { LAS unsigned char* rp = lds + (ai * 128 + wr * 64 + m * 16 + fr) * S5_LDS_ROW + (wc * 32 + 4 * fq) * 2;
#pragma unroll
                for (int bj = 0; bj < 2; ++bj)
#pragma unroll
                    for (int n = 0; n < 2; ++n) { const f32x4 a = acc[ai][bj][m][n]; u32x2 w; w.x = pk2(a[0], a[1]); w.y = pk2(a[2], a[3]); *(LAS u32x2*)(rp + (bj * 128 + n * 16) * 2) = w; } }
    }
};

struct S5Out {
    bf16_t* yb; const bf16_t* ucat; const float* dsk;
    __device__ __forceinline__ void operator()(AccRef acc, const Unit& u, int ui, int wr, int wc, int fr_, int fq_) const {
        int fr = fr_, fq = fq_; asm volatile("" : "+v"(fr), "+v"(fq));
        const int g = u.pm >> 2; const f32x4 dv = *(const f32x4*)(dsk + 16 * g + 4 * fq);
#pragma unroll
        for (int ai = 0; ai < 2; ++ai) {
            u32x2 hw[4][2][2];
#pragma unroll
            for (int m = 0; m < 4; ++m) { const int R = u.pm * 256 + ai * 128 + wr * 64 + m * 16 + fr;
#pragma unroll
                for (int bj = 0; bj < 2; ++bj)
#pragma unroll
                    for (int n = 0; n < 2; ++n) hw[m][bj][n] = *(const u32x2*)(ucat + (size_t)R * 512 + (8 * bj + 2 * wc + n) * 16 + 4 * fq); }
            asm volatile("" ::: "memory");
#pragma unroll
            for (int m = 0; m < 4; ++m) {
                const int R = u.pm * 256 + ai * 128 + wr * 64 + m * 16 + fr, bc = R & 1023, b = bc >> 7, c = bc & 127;
#pragma unroll
                for (int bj = 0; bj < 2; ++bj)
#pragma unroll
                    for (int n = 0; n < 2; ++n) {
                        const int i = 8 * bj + 2 * wc + n; const u32x2 h2 = hw[m][bj][n];
                        const float hn[4] = {bflo(h2.x), bfhi(h2.x), bflo(h2.y), bfhi(h2.y)}; const f32x4 a = acc[ai][bj][m][n]; float o[4];
#pragma unroll
                        for (int e = 0; e < 4; ++e) { const float y = a[e] + dv[e] * hn[e]; const float z = 1.5957691216057308f * (y + 0.044715f * y * y * y); o[e] = y * sigmoidf_(z); }
                        u32x2 w; w.x = pk2(o[0], o[1]); w.y = pk2(o[2], o[3]);
                        *(u32x2*)(yb + (size_t)(b * 2048 + 16 * c + i) * DM + 16 * g + 4 * fq) = w;
                    }
            }
        }
    }
};
}
constexpr size_t MiB = 1u << 20;
constexpr size_t WS_CTL = 0, CTL_ZERO_BYTES = 64 * 1024;
constexpr size_t WS_SMALL = 1 * MiB;
constexpr size_t WS_AL = WS_SMALL, WS_BTAB = WS_SMALL + 128 * 1024;
constexpr size_t WS_WA = WS_SMALL + 256 * 1024, WS_WB = WS_SMALL + 320 * 1024, WS_TW = WS_SMALL + 384 * 1024;
constexpr size_t WS_WUP = 2 * MiB;
constexpr size_t WS_WDN = 46 * MiB;
constexpr size_t WS_WQK = 68 * MiB;
constexpr size_t WS_WOUT = 86 * MiB;
constexpr size_t WS_FH = 90 * MiB;
constexpr size_t WS_WGLU = 94 * MiB;
constexpr size_t WS_WO = 98 * MiB;
constexpr size_t WS_DFT = 100 * MiB;
constexpr size_t WS_ACAT = 116 * MiB;
constexpr size_t WS_BCAT = 132 * MiB;
constexpr size_t WS_XB = 140 * MiB;
constexpr size_t WS_R = 172 * MiB;
constexpr size_t WS_GT = WS_R;
constexpr size_t WS_RF = WS_R + 96 * MiB;
constexpr size_t WS_HD = WS_R;
constexpr size_t WS_UCAT = WS_R, WS_SBUF = WS_R + 64 * MiB, WS_YBUF = WS_R + 128 * MiB;
constexpr size_t WS_QC = WS_R, WS_KC = WS_R + 32 * MiB, WS_VC = WS_R + 64 * MiB, WS_OACC = WS_R + 96 * MiB, WS_LACC = WS_R + 128 * MiB;
constexpr size_t WS_SSP = 332 * MiB;
constexpr size_t WS_END = 348 * MiB;
constexpr int CW_BAR = 4096;
constexpr int CW_ADONE = 9216;
constexpr int CW_GMAP = 8192;

constexpr int RING_BYTES = 131072;
constexpr int LDS_WB_OFF = RING_BYTES, LDS_WB_ROW = 272, LDS_WB_BYTES = 64 * LDS_WB_ROW;
constexpr int LDSCTL_OFF = LDS_WB_OFF + LDS_WB_BYTES, MISC_OFF = LDSCTL_OFF + 320;
constexpr int LDS_BYTES = 163840;
constexpr int NWAVES = 8, NTHREADS = 512;

#define XB_TMO      128
#define XB_XCNT(j)  (256  + 64 * (j))
#define XB_XSUB(j)  (1280 + 64 * (j))
#define XB_XGEN(j)  (2304 + 64 * (j))
#define XB_TOP      3328
#define XB_TOPGEN   3392
#define XCD_BAR_WORDS 3456
#define XB_SPIN_CAP (1u << 20)
__device__ __forceinline__ unsigned xb_ld(unsigned* p)              { return __hip_atomic_load(p, __ATOMIC_RELAXED, __HIP_MEMORY_SCOPE_AGENT); }
__device__ __forceinline__ unsigned xb_add(unsigned* p, unsigned v) { return __hip_atomic_fetch_add(p, v, __ATOMIC_RELAXED, __HIP_MEMORY_SCOPE_AGENT); }
__device__ __forceinline__ unsigned xb_xcc_id() { return (unsigned)__builtin_amdgcn_s_getreg((3 << 11) | 20) & 0xFu; }
#define XB_SPIN(cond, bar) do { unsigned _sp = 0; while (cond) { __builtin_amdgcn_s_sleep(1); \
    if ((++_sp & 255u) == 0u) { if (xb_ld(&(bar)[XB_TMO])) break; if (_sp > XB_SPIN_CAP) { atomicAdd(&(bar)[XB_TMO], 1u); break; } } } } while (0)
struct XcdBarrier { unsigned* bar; unsigned x; volatile LAS unsigned* st; };
__device__ __forceinline__ XcdBarrier xcd_barrier_post(unsigned* bar, volatile LAS unsigned* st) {
    XcdBarrier b; b.bar = bar; b.x = xb_xcc_id(); b.st = st;
    if (threadIdx.x == 0) (void)xb_add(&bar[XB_XCNT(b.x)], 1u);
    return b;
}
__device__ __forceinline__ void xcd_barrier_complete(unsigned* bar, unsigned x, unsigned& nloc, unsigned& nx) {
    const unsigned G = gridDim.x * gridDim.y * gridDim.z;
    unsigned sum, cnt, mine, sp = 0u;
    for (;;) {
        sum = 0u; cnt = 0u; mine = 0u;
#pragma unroll
        for (unsigned j = 0; j < 16; ++j) { const unsigned c = xb_ld(&bar[XB_XCNT(j)]); sum += c; cnt += (c > 0u) ? 1u : 0u; mine = (j == x) ? c : mine; }
        if (sum == G) break;
        __builtin_amdgcn_s_sleep(1);
        if ((++sp & 255u) == 0u) { if (xb_ld(&bar[XB_TMO])) break; if (sp > XB_SPIN_CAP) { atomicAdd(&bar[XB_TMO], 1u); break; } }
    }
    nloc = mine > 0u ? mine : 1u; nx = cnt > 0u ? cnt : 1u;
}
__device__ __forceinline__ void xcd_barrier(const XcdBarrier& b, const bool local = false, const char* pf = nullptr, const unsigned pfrs = 0u) {
    asm volatile("s_waitcnt vmcnt(0)" ::: "memory");
    __syncthreads();
    unsigned t0 = 0u, t1 = 0u, t2 = 0u;
    if (pf != nullptr && threadIdx.x >= 64) {
        const int l = (int)threadIdx.x - 64;
        const char* p0 = pf + (size_t)(l >> 2) * pfrs + (l & 3) * 128;
        const char* p1 = pf + (size_t)((l + 448) >> 2) * pfrs + ((l + 448) & 3) * 128;
        asm volatile("global_load_dword %0, %1, off" : "=v"(t0) : "v"(p0) : "memory");
        asm volatile("global_load_dword %0, %1, off" : "=v"(t1) : "v"(p1) : "memory");
        if (l < 128) { const char* p2 = pf + (size_t)((l + 896) >> 2) * pfrs + ((l + 896) & 3) * 128; asm volatile("global_load_dword %0, %1, off" : "=v"(t2) : "v"(p2) : "memory"); }
    }
    if (threadIdx.x == 0) {
        unsigned* bar = b.bar;
        __builtin_amdgcn_s_waitcnt(0);
        unsigned nloc = b.st[0], nx = b.st[1];
        if (nloc == 0u) { xcd_barrier_complete(bar, b.x, nloc, nx); b.st[0] = nloc; b.st[1] = nx; }
        const unsigned old = xb_add(&bar[XB_XSUB(b.x)], 1u);
        const unsigned gen = old / nloc;
        if (old + 1u == (gen + 1u) * nloc) {
            __builtin_amdgcn_fence(__ATOMIC_RELEASE, "agent");
            asm volatile("s_waitcnt vmcnt(0)" ::: "memory");
            if (!local) {
                const unsigned og = xb_add(&bar[XB_TOP], 1u);
                const unsigned tg = og / nx;
                if (og + 1u == (tg + 1u) * nx) xb_add(&bar[XB_TOPGEN], 1u);
                else XB_SPIN(xb_ld(&bar[XB_TOPGEN]) == tg, bar);
            }
            __builtin_amdgcn_fence(__ATOMIC_ACQUIRE, "agent");
            xb_add(&bar[XB_XGEN(b.x)], 1u);
            asm volatile("s_waitcnt vmcnt(0)" ::: "memory");
        } else {
            XB_SPIN(xb_ld(&bar[XB_XGEN(b.x)]) == gen, bar);
            __builtin_amdgcn_fence(__ATOMIC_ACQUIRE, "agent");
            asm volatile("s_waitcnt vmcnt(0)" ::: "memory");
        }
    }
    __syncthreads();
    if (pf != nullptr) { asm volatile("s_waitcnt vmcnt(0)" ::: "memory"); asm volatile("" :: "v"(t0), "v"(t1), "v"(t2)); }
}

struct Args { const float* in[20]; float* out; unsigned char* ws; int ph_lo, ph_hi; };
typedef const __attribute__((address_space(4))) Args* KArgs;
struct Frame {
    LAS unsigned char* lds; int tid, lane, wave, vcu, G; KArgs ka;
    __device__ __forceinline__ const float* in(int i) const { return ka->in[i]; }
    __device__ __forceinline__ float* out() const { return ka->out; }
    __device__ __forceinline__ unsigned char* ws() const { return ka->ws; }
};
#define LDS_WAIT() asm volatile("s_waitcnt lgkmcnt(0)" ::: "memory")
__device__ __forceinline__ float wave_sum(float v) {
#pragma unroll
    for (int o = 1; o < 64; o <<= 1) v += __shfl_xor(v, o);
    return v;
}

__device__ __forceinline__ int colmap(int n, int cmode, int cpar) {
    if (cmode == 0) return n + cpar;
    if (cmode == 1) return ((n >> 4) & 1) * cpar + 128 * (n >> 8) + 32 * ((n >> 5) & 3) + 8 * ((n >> 2) & 3) + 4 * ((n >> 7) & 1) + (n & 3);
    if (cmode == 3) return (n & ~31) + 8 * ((n >> 2) & 3) + 4 * ((n >> 4) & 1) + (n & 3) + cpar;
    const int pn = n >> 8, bj = (n >> 7) & 1, wc = (n >> 5) & 3, i = n & 31;
    if (pn >= 8) return cpar * 3072 + 2048 + (4 * (pn & 3) + wc) * 64 + 32 * bj + 8 * ((n >> 2) & 3) + 4 * ((n >> 4) & 1) + (n & 3);
    return cpar * 3072 + (pn >> 2) * 1024 + (4 * (pn & 3) + wc) * 64 + 32 * bj + i;
}
__device__ __forceinline__ int fnet_freq(int p) { return p <= 63 ? p + 1 : (p == 64 ? 0 : p); }
__device__ __forceinline__ void transpose_item(const float* W, int K, int ldsrc, bf16_t* WT, int Nd, int cmode, int cpar, const float* scale, LAS float* scr, int item, int lane, const bool kperm = false) {
    const int nblk = Nd / 32, kb = item / nblk, nb = item % nblk, k0 = 64 * kb, n0 = 32 * nb;
    const int c4 = lane & 7, kr = lane >> 3, scol = colmap(n0 + 4 * c4, cmode, cpar);
    f32x4 v[8];
#pragma unroll
    for (int i = 0; i < 8; ++i) { const int kd = k0 + 8 * i + kr, ks_ = kperm ? (kd & ~127) + fnet_freq(kd & 127) : kd; v[i] = __builtin_nontemporal_load((const f32x4*)(W + (size_t)ks_ * ldsrc + scol)); }
    const int c = lane & 7;
    f32x4 s0 = {1.f, 1.f, 1.f, 1.f}, s1 = s0;
    if (scale) { s0 = *(const f32x4*)(scale + k0 + 8 * c); s1 = *(const f32x4*)(scale + k0 + 8 * c + 4); }
#pragma unroll
    for (int i = 0; i < 8; ++i) { LAS float* d = scr + (8 * i + kr) * 33 + 4 * c4; d[0] = v[i][0]; d[1] = v[i][1]; d[2] = v[i][2]; d[3] = v[i][3]; }
    LDS_WAIT(); asm volatile("" ::: "memory");
#pragma unroll
    for (int j = 0; j < 4; ++j) { const int n = (lane >> 3) + 8 * j; const LAS float* s = scr + (8 * c) * 33 + n;
        u32x4 o; o.x = pk2(s[0 * 33] * s0[0], s[1 * 33] * s0[1]); o.y = pk2(s[2 * 33] * s0[2], s[3 * 33] * s0[3]); o.z = pk2(s[4 * 33] * s1[0], s[5 * 33] * s1[1]); o.w = pk2(s[6 * 33] * s1[2], s[7 * 33] * s1[3]);
        *(GAS u32x4*)(WT + (size_t)(n0 + n) * K + k0 + 8 * c) = o; }
    LDS_WAIT(); asm volatile("" ::: "memory");
}

__device__ __forceinline__ int t5_bucket(int rel) {
    const int n = rel < 0 ? -rel : rel; int bk;
    if (n < 8) bk = n; else if (n < 15) bk = 8; else if (n < 27) bk = 9; else if (n < 50) bk = 10; else if (n < 91) bk = 11; else if (n < 166) bk = 12; else if (n < 305) bk = 13; else if (n < 559) bk = 14; else bk = 15;
    return bk + (rel > 0 ? 16 : 0);
}

__device__ __forceinline__ void s5_prep_group(Frame& F, int g) {
    LAS float* apow = (LAS float*)F.lds;
    LAS float* bbar = apow + 2 * 17 * 132;
    LAS float* ccl = bbar + 2 * 64 * 16 * 2;
    LAS float* ktab = ccl + 2 * 16 * 64 * 2;
    const float* lre = F.in(4); const float* lim = F.in(5); const float* ldt = F.in(6); const float* bre = F.in(7); const float* bim = F.in(8); const float* cre = F.in(9); const float* cim = F.in(10);
    const int t = F.tid;
    if (t < 128) {
        const int d = t >> 6, n = t & 63, ix = (d * 64 + g) * 64 + n;
        const float lr = lre[ix], li = lim[ix], dt = expf(ldt[d * 64 + g]);
        float sn, cs; sincospif(li * dt * 0.3183098861837907f, &sn, &cs);
        const float em1 = expm1f(lr * dt), mag = em1 + 1.0f, ar = mag * cs, ai = mag * sn;
        float pr = 1.0f, pi = 0.0f;
        for (int tau = 0; tau <= 16; ++tau) { apow[(d * 17 + tau) * 132 + n * 2] = pr; apow[(d * 17 + tau) * 132 + n * 2 + 1] = pi; const float nr = pr * ar - pi * ai, ni = pr * ai + pi * ar; pr = nr; pi = ni; }
        ((float*)(F.ws() + WS_AL))[ix * 2] = apow[(d * 17 + 16) * 132 + n * 2]; ((float*)(F.ws() + WS_AL))[ix * 2 + 1] = apow[(d * 17 + 16) * 132 + n * 2 + 1];
        float sh, ch; sincospif(li * dt * 0.15915494309189535f, &sh, &ch);
        const float nr = em1 * cs - 2.0f * sh * sh, ni = ai;
        const float den = lr * lr + li * li;
        const float cr = (nr * lr + ni * li) / den, ci = (ni * lr - nr * li) / den;
        for (int q = 0; q < 16; ++q) { const float br = bre[(size_t)ix * 16 + q], bi = bim[(size_t)ix * 16 + q];
            bbar[((d * 64 + n) * 16 + q) * 2] = cr * br - ci * bi; bbar[((d * 64 + n) * 16 + q) * 2 + 1] = cr * bi + ci * br; }
    }
    for (int i = t; i < 2048; i += NTHREADS) { const int d = i >> 10, p = (i >> 6) & 15, n = i & 63; const size_t ix = ((size_t)(d * 64 + g) * 16 + p) * 64 + n; ccl[i * 2] = cre[ix]; ccl[i * 2 + 1] = cim[ix]; }
    __syncthreads();
    {
        const int d = t >> 8, p = (t >> 4) & 15, q = t & 15; float kacc[16];
#pragma unroll
        for (int tau = 0; tau < 16; ++tau) kacc[tau] = 0.f;
        for (int n = 0; n < 64; ++n) {
            const f32x2 c2 = *(const LAS f32x2*)(ccl + ((d * 16 + p) * 64 + n) * 2), b2 = *(const LAS f32x2*)(bbar + ((d * 64 + n) * 16 + q) * 2);
            const float er = c2[0] * b2[0] - c2[1] * b2[1], ei = c2[0] * b2[1] + c2[1] * b2[0];
#pragma unroll
            for (int tau = 0; tau < 16; ++tau) { const f32x2 a2 = *(const LAS f32x2*)(apow + (d * 17 + tau) * 132 + n * 2); kacc[tau] += er * a2[0] - ei * a2[1]; }
        }
#pragma unroll
        for (int tau = 0; tau < 16; ++tau) ktab[(d * 16 + tau) * 257 + p * 16 + q] = kacc[tau];
    }
    __syncthreads();
    bf16_t* acat = (bf16_t*)(F.ws() + WS_ACAT) + (size_t)g * 256 * 512;
    for (int pc = t; pc < 256 * 32; pc += NTHREADS) {
        const int R = pc >> 5, c0 = (pc & 31) * 8, i = R >> 4, p = R & 15, j = c0 >> 4, q0 = c0 & 15; float v[8];
#pragma unroll
        for (int e = 0; e < 8; ++e) { float s = 0.f; if (j <= i) s += ktab[(0 * 16 + (i - j)) * 257 + p * 16 + q0 + e]; if (j >= i) s += ktab[(1 * 16 + (j - i)) * 257 + p * 16 + q0 + e]; v[e] = s; }
        u32x4 o; o.x = pk2(v[0], v[1]); o.y = pk2(v[2], v[3]); o.z = pk2(v[4], v[5]); o.w = pk2(v[6], v[7]);
        *(GAS u32x4*)(acat + (size_t)R * 512 + c0) = o;
    }
    for (int pc = t; pc < 256 * 32; pc += NTHREADS) {
        const int R = pc >> 5, ci_ = (pc & 31) * 8, i = R >> 4, p = R & 15, d = ci_ >> 7, part = (ci_ >> 6) & 1, n0 = ci_ & 63, tau = d == 0 ? i + 1 : 16 - i; float v[8];
        const LAS f32x4* cp = (const LAS f32x4*)(ccl + ((d * 16 + p) * 64 + n0) * 2); const LAS f32x4* ap = (const LAS f32x4*)(apow + (d * 17 + tau) * 132 + n0 * 2);
#pragma unroll
        for (int e2 = 0; e2 < 4; ++e2) { const f32x4 c = cp[e2], a = ap[e2];
            v[2 * e2] = part == 0 ? (c[0] * a[0] - c[1] * a[1]) : -(c[0] * a[1] + c[1] * a[0]); v[2 * e2 + 1] = part == 0 ? (c[2] * a[2] - c[3] * a[3]) : -(c[2] * a[3] + c[3] * a[2]); }
        u32x4 o; o.x = pk2(v[0], v[1]); o.y = pk2(v[2], v[3]); o.z = pk2(v[4], v[5]); o.w = pk2(v[6], v[7]);
        *(GAS u32x4*)(acat + (size_t)R * 512 + 256 + ci_) = o;
    }
    bf16_t* bcat = (bf16_t*)(F.ws() + WS_BCAT) + (size_t)g * 256 * 256;
    for (int pc = t; pc < 256 * 32; pc += NTHREADS) {
        const int Rb = pc >> 5, c0 = (pc & 31) * 8, d = Rb >> 7, part = (Rb >> 6) & 1, n = Rb & 63, j = c0 >> 4, q0 = c0 & 15, tau = d == 0 ? 15 - j : j;
        const f32x2 a2 = *(const LAS f32x2*)(apow + (d * 17 + tau) * 132 + n * 2); const float ar = a2[0], ai = a2[1]; float v[8];
        const LAS f32x4* bp = (const LAS f32x4*)(bbar + ((d * 64 + n) * 16 + q0) * 2);
#pragma unroll
        for (int e2 = 0; e2 < 4; ++e2) { const f32x4 b4 = bp[e2]; v[2 * e2] = part == 0 ? (ar * b4[0] - ai * b4[1]) : (ar * b4[1] + ai * b4[0]); v[2 * e2 + 1] = part == 0 ? (ar * b4[2] - ai * b4[3]) : (ar * b4[3] + ai * b4[2]); }
        u32x4 o; o.x = pk2(v[0], v[1]); o.y = pk2(v[2], v[3]); o.z = pk2(v[4], v[5]); o.w = pk2(v[6], v[7]);
        *(GAS u32x4*)(bcat + (size_t)Rb * 256 + c0) = o;
    }
    __syncthreads();
}

__device__ __forceinline__ void fh_item(Frame& F, int item) {
    const int ls = item >> 5, pn = (item >> 3) & 3, rg = item & 7, bj = rg >> 2, q = rg & 3, layer = ls == 0 ? 0 : 3, t = F.tid;
    bf16_t* dst = (bf16_t*)(F.ws() + WS_FH) + ((size_t)(ls * 4 + pn) * 256 + 32 * rg) * 256;
    const float* gn = F.in(1) + layer * DM + 256 * pn;
    for (int i = t; i < 32 * 256; i += NTHREADS) { const int r = i >> 8, kk = i & 255, part = r >> 4, ch = r & 15, m = kk & 127;
        float v = 0.f;
        if ((kk >> 7) == bj) {
            const bool special = (q == 3 && ch == 15); const int k = special ? (part ? 64 : 0) : 16 * q + 1 + ch;
            float sn, cs; sincospif((float)((k * m) & 127) * (1.0f / 64.0f), &sn, &cs);
            v = ((part && !special) ? sn : cs) * gn[kk] * 0.08838834764831845f; }
        dst[i] = (bf16_t)f2bf(v); }
}

__device__ __forceinline__ void dft_tables_item(Frame& F) {
    bf16_t* wa = (bf16_t*)(F.ws() + WS_WA); bf16_t* wb = (bf16_t*)(F.ws() + WS_WB); float* tw = (float*)(F.ws() + WS_TW);
    const int t = F.tid;
    for (int i = t; i < 64 * 64; i += NTHREADS) { const int r = i >> 6, k = i & 63, po = r >> 5, s1 = r & 31, pi = k >> 5, s1p = k & 31;
        float sn, cs; sincospif((float)((s1 * s1p) & 31) * (1.0f / 16.0f), &sn, &cs);
        const float v = po == 0 ? (pi == 0 ? cs : -sn) : (pi == 0 ? -sn : -cs); wa[i] = (bf16_t)f2bf(v); }
    for (int i = t; i < 64 * 128; i += NTHREADS) { const int s2 = i >> 7, k = i & 127, part = k >> 6, s2p = k & 63;
        float sn, cs; sincospif((float)((s2 * s2p) & 63) * (1.0f / 32.0f), &sn, &cs);
        wb[i] = (bf16_t)f2bf((part == 0 ? cs : sn) * 0.022097086912079608f); }
    for (int i = t; i < 32 * 64; i += NTHREADS) { const int s1 = i >> 6, s2p = i & 63; float sn, cs; sincospif((float)(s1 * s2p) * (1.0f / 1024.0f), &sn, &cs); tw[2 * i] = cs; tw[2 * i + 1] = sn; }
}

__device__ __forceinline__ void prep_transposes(Frame& F, int set, int gw, int NGW) {
    LAS float* scr = (LAS float*)(F.lds + F.wave * 16384);
    constexpr int I_UP = 16 * 176, I_DN = 44 * 32, I_QKV = 16 * 96, I_WO = 16 * 32, I_GLU = 16 * 64;
    const int l = set;
    const int nitems = I_UP + I_DN + (set == 1 ? I_GLU + I_WO : 0) + (set == 2 ? 3 * I_QKV : 0) + ((set == 0 || set == 3) ? I_WO : 0);
    for (int it = gw; it < nitems; it += NGW) {
        int r = it;
        if (r < I_UP) { transpose_item(F.in(18) + (size_t)l * DM * 2 * DFF, DM, 2 * DFF, (bf16_t*)(F.ws() + WS_WUP) + (size_t)l * 2 * DFF * DM, 2 * DFF, 1, DFF, F.in(2) + l * DM, scr, r, F.lane); continue; } r -= I_UP;
        if (r < I_DN) { transpose_item(F.in(19) + (size_t)l * DFF * DM, DFF, DM, (bf16_t*)(F.ws() + WS_WDN) + (size_t)l * DM * DFF, DM, 3, 0, nullptr, scr, r, F.lane); continue; } r -= I_DN;
        if (set == 0 || set == 3) { const int js = set == 0 ? 0 : 1; transpose_item(F.in(3) + (size_t)js * DM * DM, DM, DM, (bf16_t*)(F.ws() + WS_WOUT) + (size_t)js * DM * DM, DM, 3, 0, nullptr, scr, r, F.lane, true); continue; }
        if (set == 1) { if (r < I_GLU) transpose_item(F.in(12), DM, 2 * DM, (bf16_t*)(F.ws() + WS_WGLU), 2 * DM, 1, DM, nullptr, scr, r, F.lane); else transpose_item(F.in(16), DM, DM, (bf16_t*)(F.ws() + WS_WO), DM, 3, 0, nullptr, scr, r - I_GLU, F.lane); continue; }
        { const int g = r / I_QKV; transpose_item(F.in(13), DM, 9216, (bf16_t*)(F.ws() + WS_WQK) + (size_t)g * 3072 * DM, 3072, 2, g, F.in(1) + 2 * DM, scr, r % I_QKV, F.lane); }
    }
}
__device__ __forceinline__ void prep_background(Frame& F, int L) {
    const int bb = (int)blockIdx.x - 128; if (bb < 0 || L > 2) return;
    if (L == 0) prep_transposes(F, 1, bb * NWAVES + F.wave, 128 * NWAVES);
    else prep_transposes(F, L + 1, bb * NWAVES + F.wave, 128 * NWAVES);
    if (L == 2 && bb < 32) fh_item(F, 32 + bb);
}

constexpr int PREP_NWG = 192;
constexpr int PREP_XSPLIT = 12288;
__device__ __forceinline__ void prep_xconv(Frame& F, int r0, int r1, int gw, int NGW) {
    float* ss0 = (float*)(F.ws() + WS_SSP); bf16_t* xb = (bf16_t*)(F.ws() + WS_XB);
    for (int m0 = r0 + gw; m0 < r1; m0 += 4 * NGW) {
        f32x4 v[4][4];
#pragma unroll
        for (int r = 0; r < 4; ++r) { const int mr = m0 + r * NGW < r1 ? m0 + r * NGW : m0; const GAS f32x4* xr = (const GAS f32x4*)(F.in(0) + (size_t)mr * DM) + F.lane;
#pragma unroll
            for (int j = 0; j < 4; ++j) v[r][j] = __builtin_nontemporal_load(&xr[64 * j]); }
#pragma unroll
        for (int r = 0; r < 4; ++r) { const int m = m0 + r * NGW; float s = 0.f; if (m >= r1) continue;
#pragma unroll
            for (int j = 0; j < 4; ++j) s += (v[r][j][0] * v[r][j][0] + v[r][j][1] * v[r][j][1]) + (v[r][j][2] * v[r][j][2] + v[r][j][3] * v[r][j][3]);
            s = wave_sum(s); if (F.lane < 16) ss0[(size_t)m * 32 + F.lane] = F.lane == 0 ? s : 0.f;
            GAS u32x2* o8 = (GAS u32x2*)(xb + (size_t)m * DM) + F.lane;
#pragma unroll
            for (int j = 0; j < 4; ++j) { u32x2 w; w.x = pk2(v[r][j][0], v[r][j][1]); w.y = pk2(v[r][j][2], v[r][j][3]); o8[64 * j] = w; } } }
}
__device__ __forceinline__ void phase_prep(Frame& F) {
    const int bx = (int)blockIdx.x;
    if (bx >= PREP_NWG) { s5_prep_group(F, bx - PREP_NWG); prep_xconv(F, PREP_XSPLIT, MTOK, (bx - PREP_NWG) * NWAVES + F.wave, (256 - PREP_NWG) * NWAVES); return; }
    for (int it = bx; it < 32 + 1; it += PREP_NWG) {
        if (it < 32) fh_item(F, it); else dft_tables_item(F);
    }
    __syncthreads();
    { const float* rb = F.in(17); float* bt = (float*)(F.ws() + WS_BTAB);
      for (int i = bx * NTHREADS + F.tid; i < 48 * 192; i += PREP_NWG * NTHREADS) { const int gh = i / 192, rel = i % 192 - 96, g = gh >> 4, dil = g == 0 ? 1 : (g == 1 ? 4 : 16);
          float gq = 0.f, gk = 0.f; for (int d = 0; d < 64; ++d) { gq = fmaxf(gq, fabsf(F.in(14)[g * 64 + d])); gk = fmaxf(gk, fabsf(F.in(15)[g * 64 + d])); }
          const float cb = 8.0f * LOG2E * gq * gk;
          bt[i] = rel == -96 ? cb : ((rel >= -64 && rel <= 64) ? rb[t5_bucket(rel * dil) * 48 + gh] * LOG2E - cb : -1e30f); } }
    const int gw = bx * NWAVES + F.wave, NGW = PREP_NWG * NWAVES;
    prep_transposes(F, 0, gw, NGW);
    prep_xconv(F, 0, PREP_XSPLIT, gw, NGW);
}

__device__ __forceinline__ void s5_gather(Frame& F, int pm) {
    const bf16_t* x = (const bf16_t*)(F.ws() + WS_XB); const float* ss = (const float*)(F.ws() + WS_SSP) + (size_t)2 * MTOK * 32; bf16_t* uc = (bf16_t*)(F.ws() + WS_UCAT);
    const int g = pm >> 2, t2 = 2 * (pm & 3);
    const float* gn = F.in(1) + 1 * DM + 16 * g;
    f32x4 gv[4];
#pragma unroll
    for (int j = 0; j < 4; ++j) gv[j] = *(const f32x4*)(gn + 4 * j);
    for (int i0 = 0; i0 < 8; i0 += 4) {
        u32x4 x0[4], x1[4]; float r[4];
#pragma unroll
        for (int i = 0; i < 4; ++i) { const int loc = F.tid + 512 * (i0 + i), tok = (t2 + (loc >> 11)) * 2048 + (loc & 2047);
            const u32x4* xp = (const u32x4*)(x + (size_t)tok * DM + 16 * g); x0[i] = xp[0]; x1[i] = xp[1]; r[i] = rstd_tok(ss, tok, 4); }
#pragma unroll
        for (int i = 0; i < 4; ++i) { const int loc = F.tid + 512 * (i0 + i), b = t2 + (loc >> 11), s = loc & 2047, c = s >> 4, jj = s & 15; f32x4 v[4];
            v[0] = (f32x4){bflo(x0[i].x), bfhi(x0[i].x), bflo(x0[i].y), bfhi(x0[i].y)} * gv[0] * r[i]; v[1] = (f32x4){bflo(x0[i].z), bfhi(x0[i].z), bflo(x0[i].w), bfhi(x0[i].w)} * gv[1] * r[i];
            v[2] = (f32x4){bflo(x1[i].x), bfhi(x1[i].x), bflo(x1[i].y), bfhi(x1[i].y)} * gv[2] * r[i]; v[3] = (f32x4){bflo(x1[i].z), bfhi(x1[i].z), bflo(x1[i].w), bfhi(x1[i].w)} * gv[3] * r[i];
            u32x4 o0, o1; o0.x = pk2(v[0][0], v[0][1]); o0.y = pk2(v[0][2], v[0][3]); o0.z = pk2(v[1][0], v[1][1]); o0.w = pk2(v[1][2], v[1][3]);
            o1.x = pk2(v[2][0], v[2][1]); o1.y = pk2(v[2][2], v[2][3]); o1.z = pk2(v[3][0], v[3][1]); o1.w = pk2(v[3][2], v[3][3]);
            bf16_t* dp = uc + ((size_t)(g * 1024 + b * 128 + c) * 512 + jj * 16);
            *(u32x4*)dp = o0; *(u32x4*)(dp + 8) = o1; }
    }
}
__device__ __forceinline__ void phase_s5scan(Frame& F, int pm) {
    if (F.wave >= 4) return;
    const int dir = F.wave & 1, b = 2 * (pm & 3) + (F.wave >> 1), g = pm >> 2, n = F.lane;
    const float* al = (const float*)(F.ws() + WS_AL) + ((size_t)(dir * 64 + g) * 64 + n) * 2; const float ar = al[0], ai = al[1];
    const LAS unsigned char* sl = F.lds + ((F.wave >> 1) * 128) * epi::S5_LDS_ROW + (dir * 128 + n) * 2;
    bf16_t* uc = (bf16_t*)(F.ws() + WS_UCAT) + (size_t)(g * 1024 + b * 128) * 512 + 256 + dir * 128 + n;
    float hr = 0.f, hi = 0.f;
    for (int c8 = 0; c8 < 128; c8 += 8) {
        float sr[8], si[8];
#pragma unroll
        for (int k = 0; k < 8; ++k) { const int c = dir == 0 ? c8 + k : 127 - (c8 + k); sr[k] = bf2f(*(const LAS bf16_t*)(sl + c * epi::S5_LDS_ROW)); si[k] = bf2f(*(const LAS bf16_t*)(sl + c * epi::S5_LDS_ROW + 128)); }
#pragma unroll
        for (int k = 0; k < 8; ++k) { const int c = dir == 0 ? c8 + k : 127 - (c8 + k);
            uc[(size_t)c * 512] = (bf16_t)f2bf(hr); uc[(size_t)c * 512 + 64] = (bf16_t)f2bf(hi);
            const float nr = ar * hr - ai * hi + sr[k], ni = ar * hi + ai * hr + si[k]; hr = nr; hi = ni; }
    }
}

typedef short v4i16_t __attribute__((ext_vector_type(4)));
__device__ __forceinline__ v4i16_t lds_tr(LAS unsigned char* p) { return __builtin_amdgcn_ds_read_tr16_b64_v4i16((LAS v4i16_t*)p); }
__device__ __forceinline__ void phase_fdft(Frame& F) {
    const int lane = F.lane, w = F.wave, c31 = lane & 31, h = lane >> 5, blk = (lane >> 4) & 1, q = (lane & 15) >> 2, p = lane & 3;
    const bf16_t* gt = (const bf16_t*)(F.ws() + WS_GT); bf16_t* rf = (bf16_t*)(F.ws() + WS_RF);
    const bf16_t* wa = (const bf16_t*)(F.ws() + WS_WA); const bf16_t* wb = (const bf16_t*)(F.ws() + WS_WB); const float* tw = (const float*)(F.ws() + WS_TW);
    LAS unsigned char* img = F.lds; LAS unsigned char* wbl = F.lds + LDS_WB_OFF;
    for (int i = F.tid; i < 64 * 16; i += NTHREADS) { const int r = i >> 4, ch = i & 15; *(LAS u32x4*)(wbl + r * LDS_WB_ROW + ch * 16) = *(const u32x4*)(wb + r * 128 + ch * 8); }
    {
        const int b = (int)blockIdx.x & 7, nblk = (int)blockIdx.x >> 3, it = b * 64 + nblk, jb = nblk >> 2, qs = nblk & 3;
        LAS bf16_t* stash = (LAS bf16_t*)(F.lds + LDSCTL_OFF + 4096);
        {
            const char* src = (const char*)(gt + (size_t)it * 65536) + lane * 16;
#pragma unroll
            for (int i = 0; i < 16; ++i) __builtin_amdgcn_global_load_lds((const unsigned*)(src + (w * 16 + i) * 1024), (LAS unsigned*)(img + (w * 16 + i) * 1024), 16, 0, 0);
            asm volatile("s_waitcnt vmcnt(0)" ::: "memory");
        }
        __syncthreads();
        {
            bf16x8 wf[2][4];
#pragma unroll
            for (int nt = 0; nt < 2; ++nt)
#pragma unroll
                for (int ks = 0; ks < 4; ++ks) wf[nt][ks] = *(const bf16x8*)(wa + (nt * 32 + c31) * 64 + 16 * ks + 8 * h);
            for (int cgi = 0; cgi < 4; ++cgi) {
                const int s2b = 2 * (w + 8 * cgi), s2r = s2b + blk;
                f32x16 acc[2] = {{}, {}};
#pragma unroll
                for (int ks = 0; ks < 4; ++ks) {
                    const int pi = ks >> 1, s1p0 = 16 * (ks & 1) + 8 * h + q;
                    LAS unsigned char* a0 = img + ((pi * 64 + s2r) * 32 + ((s1p0) ^ (blk << 2))) * 32 + 8 * p;
                    LAS unsigned char* a1 = img + ((pi * 64 + s2r) * 32 + ((s1p0 + 4) ^ (blk << 2))) * 32 + 8 * p;
                    const v4i16_t lo = lds_tr(a0), hi = lds_tr(a1);
                    const bf16x8 af = {lo[0], lo[1], lo[2], lo[3], hi[0], hi[1], hi[2], hi[3]};
#pragma unroll
                    for (int nt = 0; nt < 2; ++nt) acc[nt] = __builtin_amdgcn_mfma_f32_32x32x16_bf16(af, wf[nt][ks], acc[nt], 0, 0, 0);
                }
#pragma unroll
                for (int jj = 0; jj < 2; ++jj) {
                    const int s2 = s2b + jj; f32x2 cs; { float sn_, cs_; sincospif((float)(c31 * s2) * (1.0f / 1024.0f), &sn_, &cs_); cs[0] = cs_; cs[1] = sn_; }
#pragma unroll
                    for (int u2 = 0; u2 < 2; ++u2) {
                        const int tq = 2 * jj + u2, nq = 2 * u2 + h; float re[4], im[4];
#pragma unroll
                        for (int e = 0; e < 4; ++e) { const float tr = acc[0][4 * tq + e], ti = acc[1][4 * tq + e]; re[e] = tr * cs[0] + ti * cs[1]; im[e] = ti * cs[0] - tr * cs[1]; }
                        const int slot = (c31 ^ (((s2 & 3) * 4 + nq) * 2)) * 8;
                        u32x2 wr_, wi_; wr_.x = pk2(re[0], re[1]); wr_.y = pk2(re[2], re[3]); wi_.x = pk2(im[0], im[1]); wi_.y = pk2(im[2], im[3]);
                        *(LAS u32x2*)(img + ((0 * 64 + s2) * 4 + nq) * 256 + slot) = wr_;
                        *(LAS u32x2*)(img + ((1 * 64 + s2) * 4 + nq) * 256 + slot) = wi_;
                    }
                }
                asm volatile("s_waitcnt lgkmcnt(0)" ::: "memory");
            }
        }
        __syncthreads();
        {
            for (int sbi = 0; sbi < 2; ++sbi) {
                const int s1b = 2 * (w + 8 * sbi), s1r = s1b + blk;
                f32x16 acc[2] = {{}, {}}, aci[2] = {{}, {}};
#pragma unroll
                for (int ks = 0; ks < 8; ++ks) {
                    const int part = ks >> 2, s2p0 = 16 * (ks & 3) + 8 * h + q;
                    const int slot = (s1r ^ ((q * 4 + p) * 2)) * 8;
                    const v4i16_t lo = lds_tr(img + ((part * 64 + s2p0) * 4 + p) * 256 + slot), hi = lds_tr(img + ((part * 64 + s2p0 + 4) * 4 + p) * 256 + slot);
                    const bf16x8 af = {lo[0], lo[1], lo[2], lo[3], hi[0], hi[1], hi[2], hi[3]};
#pragma unroll
                    for (int nt = 0; nt < 2; ++nt) { const bf16x8 wfr = *(const LAS bf16x8*)(wbl + (nt * 32 + c31) * LDS_WB_ROW + 32 * ks + 16 * h);
                        acc[nt] = __builtin_amdgcn_mfma_f32_32x32x16_bf16(af, wfr, acc[nt], 0, 0, 0); }
                    if (qs == 3) {
#pragma unroll
                        for (int nt = 0; nt < 2; ++nt) { u32x4 wi = *(const LAS u32x4*)(wbl + (nt * 32 + c31) * LDS_WB_ROW + 32 * (ks ^ 4) + 16 * h);
                            if (part == 0) { wi.x ^= 0x80008000u; wi.y ^= 0x80008000u; wi.z ^= 0x80008000u; wi.w ^= 0x80008000u; }
                            aci[nt] = __builtin_amdgcn_mfma_f32_32x32x16_bf16(af, __builtin_bit_cast(bf16x8, wi), aci[nt], 0, 0, 0); }
                    }
                }
                asm volatile("" ::: "memory");
#pragma unroll
                for (int nt = 0; nt < 2; ++nt)
#pragma unroll
                    for (int x = 0; x < 2; ++x) {
                        const int s = s1b + x + 32 * (32 * nt + c31), tok = b * 2048 + s, tokm = b * 2048 + ((2048 - s) & 2047);
                        { u32x2 q0, q1; q0.x = pk2(acc[nt][8 * x + 0], acc[nt][8 * x + 1]); q0.y = pk2(acc[nt][8 * x + 2], acc[nt][8 * x + 3]); q1.x = pk2(acc[nt][8 * x + 4], acc[nt][8 * x + 5]); q1.y = pk2(acc[nt][8 * x + 6], acc[nt][8 * x + 7]);
                          const u32x2 snd = h ? q0 : q1; u32x2 rcv; rcv.x = (unsigned)__shfl_xor((int)snd.x, 32); rcv.y = (unsigned)__shfl_xor((int)snd.y, 32);
                          u32x4 wv; if (h == 0) { wv.x = q0.x; wv.y = q0.y; wv.z = rcv.x; wv.w = rcv.y; } else { wv.x = rcv.x; wv.y = rcv.y; wv.z = q1.x; wv.w = q1.y; }
                          *(u32x4*)(rf + (size_t)tok * DM + 128 * jb + 16 * qs + 8 * h) = wv;
                          u32x4 wm; wm.x = (wv.w << 16) | (wv.w >> 16); wm.y = (wv.z << 16) | (wv.z >> 16); wm.z = (wv.y << 16) | (wv.y >> 16); wm.w = (wv.x << 16) | (wv.x >> 16);
                          *(u32x4*)(rf + (size_t)tokm * DM + 128 * jb + 120 - 16 * qs - 8 * h) = wm; }
                        if (qs == 3 && h == 1) { stash[s] = (bf16_t)f2bf(acc[nt][4 * (2 * x + 1) + 3]); stash[2048 + s] = (bf16_t)f2bf(aci[nt][4 * (2 * x + 1) + 3]); }
                    }
            }
        }
        if (qs == 3) {
            asm volatile("s_waitcnt vmcnt(0) lgkmcnt(0)" ::: "memory");
            __syncthreads();
            for (int s = F.tid; s < 2048; s += NTHREADS) { const int sm = (2048 - s) & 2047;
                const float ca = 0.5f * (bf2f(stash[s]) + bf2f(stash[sm])), cb = -0.5f * (bf2f(stash[2048 + s]) + bf2f(stash[2048 + sm]));
                bf16_t* o = rf + (size_t)(b * 2048 + s) * DM + 128 * jb; o[64] = (bf16_t)f2bf(ca); o[63] = (bf16_t)f2bf(cb); }
        }
        __syncthreads();
    }
}

constexpr int AT_KROW = 144, AT_VROW = 192, AT_KT = 0, AT_VT = 384 * AT_KROW, AT_TAB = AT_VT + 384 * AT_VROW;
__device__ __forceinline__ void phase_attn(Frame& F, int g) {
    const int dil = g == 0 ? 1 : (g == 1 ? 4 : 16), seg = 2048 / dil, lane = F.lane, q = lane & 31, h = lane >> 5, t = F.tid, w = F.wave;
    const bf16_t* Qc = (const bf16_t*)(F.ws() + WS_QC); const bf16_t* Kc = (const bf16_t*)(F.ws() + WS_KC); const bf16_t* Vc = (const bf16_t*)(F.ws() + WS_VC);
    bf16_t* oacc = (bf16_t*)(F.ws() + WS_OACC); float* lacc = (float*)(F.ws() + WS_LACC);
    LAS unsigned char* Kt = F.lds + AT_KT; LAS unsigned char* Vt = F.lds + AT_VT; LAS float* tab = (LAS float*)(F.lds + AT_TAB);
    const int vb = F.vcu, b = vb >> 5, hh = (vb >> 1) & 15, half = vb & 1;
    if (t < 192) tab[t] = ((const float*)(F.ws() + WS_BTAB))[(g * 16 + hh) * 192 + t];
    u32x4 kst[6], vst[6];
    const __amdgpu_buffer_rsrc_t krs = __builtin_amdgcn_make_buffer_rsrc((void*)(Kc + (size_t)b * 2048 * DM), 0, 2048 * 2048, 0x00020000);
    const __amdgpu_buffer_rsrc_t vrs = __builtin_amdgcn_make_buffer_rsrc((void*)(Vc + (size_t)b * 2048 * DM), 0, 2048 * 2048, 0x00020000);
    const int kvo = (t >> 3) * 2048 + hh * 128 + (t & 7) * 16;
    const int kls = (t >> 3) * AT_KROW + (t & 7) * 16, vls = (t >> 3) * AT_VROW + (t & 7) * 16;
#define AT_LOAD(cs_) do { _Pragma("unroll") for (int i = 0; i < 6; ++i) { \
        kst[i] = __builtin_bit_cast(u32x4, __builtin_amdgcn_raw_buffer_load_b128(krs, kvo, ((cs_) - 64 + 64 * i) * 2048, 0)); \
        vst[i] = __builtin_bit_cast(u32x4, __builtin_amdgcn_raw_buffer_load_b128(vrs, kvo, ((cs_) - 64 + 64 * i) * 2048, 0)); } } while (0)
#define AT_STORE() do { _Pragma("unroll") for (int i = 0; i < 6; ++i) { \
        *(LAS u32x4*)(Kt + kls + i * (64 * AT_KROW)) = kst[i]; *(LAS u32x4*)(Vt + vls + i * (64 * AT_VROW)) = vst[i]; } } while (0)
    AT_LOAD(half * 1024);
    bf16x8 qf[4], qn[4];
    { const bf16_t* qp = Qc + (size_t)(b * 2048 + half * 1024 + 32 * w + q) * DM + hh * 64 + 8 * h;
#pragma unroll
      for (int s = 0; s < 4; ++s) qf[s] = *(const bf16x8*)(qp + 16 * s); }
    AT_STORE();
    __syncthreads();
    for (int rd = 0; rd < 4; ++rd) {
        const int cs = half * 1024 + 256 * rd;
        if (rd < 3) AT_LOAD(cs + 256);
        const int vin0 = cs + 32 * w, r = vin0 / seg, m0 = vin0 & (seg - 1);
        const int tok = b * 2048 + (m0 + q) * dil + r;
        if (rd < 3) { const bf16_t* qp = Qc + (size_t)(b * 2048 + vin0 + 256 + q) * DM + hh * 64 + 8 * h;
#pragma unroll
            for (int s = 0; s < 4; ++s) qn[s] = *(const bf16x8*)(qp + 16 * s); }
        u32x2 old[2][4]; float lo = 0.f;
        if (g != 0) { lo = lacc[tok * 16 + hh];
#pragma unroll
            for (int db = 0; db < 2; ++db)
#pragma unroll
                for (int tq = 0; tq < 4; ++tq) old[db][tq] = *(const u32x2*)(oacc + (size_t)tok * DM + hh * 64 + 32 * db + 8 * tq + 4 * h); }
        f32x16 O[2] = {{}, {}}; float l = 0.f;
#pragma unroll
        for (int kb = 0; kb < 5; ++kb) {
            const int mk0 = m0 - 64 + 32 * kb; const bool valid = (mk0 >= 0) && (mk0 < seg);
            if (!valid) continue;
            const LAS unsigned char* kp = Kt + (32 * (w + kb) + q) * AT_KROW + 16 * h;
            f32x16 a = {};
#pragma unroll
            for (int s = 0; s < 4; ++s) { const bf16x8 kf = *(const LAS bf16x8*)(kp + 32 * s); a = __builtin_amdgcn_mfma_f32_32x32x16_bf16(kf, qf[s], a, 0, 0, 0); }
#pragma unroll
            for (int e = 0; e < 16; ++e) { const int key = (e & 3) + 8 * (e >> 2) + 4 * h; const float bias = tab[32 * kb - 64 + key - q + 96]; const float p = fast_exp2(a[e] + bias); a[e] = p; l += p; }
#pragma unroll
            for (int s2 = 0; s2 < 2; ++s2) {
                u32x4 pw; pw.x = pk2(a[8 * s2 + 0], a[8 * s2 + 1]); pw.y = pk2(a[8 * s2 + 2], a[8 * s2 + 3]); pw.z = pk2(a[8 * s2 + 4], a[8 * s2 + 5]); pw.w = pk2(a[8 * s2 + 6], a[8 * s2 + 7]);
                const bf16x8 pb = __builtin_bit_cast(bf16x8, pw);
#pragma unroll
                for (int db = 0; db < 2; ++db) {
                    LAS unsigned char* va = Vt + (32 * (w + kb) + 16 * s2 + 4 * h + ((lane & 15) >> 2)) * AT_VROW + (32 * db + 16 * ((lane >> 4) & 1) + 4 * (lane & 3)) * 2;
                    const v4i16_t lo = lds_tr(va), hi = lds_tr(va + 8 * AT_VROW);
                    const bf16x8 vf = {lo[0], lo[1], lo[2], lo[3], hi[0], hi[1], hi[2], hi[3]};
                    O[db] = __builtin_amdgcn_mfma_f32_32x32x16_bf16(vf, pb, O[db], 0, 0, 0);
                }
            }
            __builtin_amdgcn_sched_barrier(0);
        }
        l += __shfl_xor(l, 32);
        const float mx = tab[0];
        {
            const float inv = fast_rcp(l), lse = mx + __builtin_amdgcn_logf(l);
            float wo = 0.f, wn = 1.f, ln = lse;
            if (g != 0) { const float mm = fmaxf(lo, lse); ln = mm + __builtin_amdgcn_logf(fast_exp2(lo - mm) + fast_exp2(lse - mm)); wo = fast_exp2(lo - ln); wn = fast_exp2(lse - ln); }
            wn *= inv;
#pragma unroll
            for (int db = 0; db < 2; ++db)
#pragma unroll
                for (int tq = 0; tq < 4; ++tq) {
                    bf16_t* op = oacc + (size_t)tok * DM + hh * 64 + 32 * db + 8 * tq + 4 * h; float o[4];
#pragma unroll
                    for (int e = 0; e < 4; ++e) o[e] = O[db][4 * tq + e] * wn;
                    if (g != 0) { const u32x2 ow = old[db][tq]; o[0] += wo * bflo(ow.x); o[1] += wo * bfhi(ow.x); o[2] += wo * bflo(ow.y); o[3] += wo * bfhi(ow.y); }
                    u32x2 wv; wv.x = pk2(o[0], o[1]); wv.y = pk2(o[2], o[3]); *(u32x2*)op = wv;
                }
            if (h == 0) lacc[tok * 16 + hh] = ln;
        }
        __syncthreads();
        if (rd < 3) { AT_STORE(); __syncthreads();
#pragma unroll
            for (int s = 0; s < 4; ++s) qf[s] = qn[s]; }
    }
#undef AT_LOAD
#undef AT_STORE
}
#ifndef MK_ONE_LAUNCH
#define MK_ONE_LAUNCH 1
#endif
constexpr int NPHASES = 26;
enum PhaseKind { PK_PREP = 0, PK_G1, PK_G2, PK_UP, PK_DOWN, PK_S5PRE, PK_S5A, PK_S5SCAN, PK_S5C, PK_GLU, PK_QK, PK_ATT, PK_WO, PK_FC };
struct PhaseDesc { int kind, layer, g, nobar; };
__device__ __forceinline__ PhaseDesc phase_desc(int ph) {
    PhaseDesc d; d.g = 0; d.nobar = 0;
    if (ph == 0) { d.kind = PK_PREP; d.layer = 0; return d; }
    if (ph <= 5) { d.layer = 0; d.kind = ph == 1 ? PK_G1 : ph == 2 ? PK_G2 : ph == 3 ? PK_FC : ph == 4 ? PK_UP : PK_DOWN; return d; }
    if (ph <= 11) { d.layer = 1; d.kind = ph == 6 ? PK_S5A : ph == 7 ? PK_S5SCAN : ph == 8 ? PK_S5C : ph == 9 ? PK_GLU : ph == 10 ? PK_UP : PK_DOWN; d.nobar = (ph == 6 || ph == 7) ? 2 : 0; return d; }
    if (ph <= 20) { d.layer = 2; if (ph <= 17) { const int q = ph - 12; d.g = q >> 1; d.kind = (q & 1) ? PK_ATT : PK_QK; } else d.kind = ph == 18 ? PK_WO : ph == 19 ? PK_UP : PK_DOWN; return d; }
    d.layer = 3; d.kind = ph == 21 ? PK_G1 : ph == 22 ? PK_G2 : ph == 23 ? PK_FC : ph == 24 ? PK_UP : PK_DOWN; return d;
}

struct EpiAny {
    int pk, L, gg; LAS float* rl;
    __device__ __forceinline__ void pre(const pg8::StaticOrder& S) const {
        if (!(pk == PK_G1 || pk == PK_UP || pk == PK_QK)) return;
        KArgs ka = (KArgs)__builtin_amdgcn_kernarg_segment_ptr(); asm volatile("" : "+s"(ka));
        int t = threadIdx.x; asm volatile("" : "+v"(t));
        unsigned char* ws = ka->ws; const float* ssb = (const float*)(ws + WS_SSP);
        const float* ssq = pk == PK_G1 ? ssb + (size_t)(2 * L) * MTOK * 32 : pk == PK_UP ? ssb + (size_t)(2 * L + 1) * MTOK * 32 : ssb + (size_t)4 * MTOK * 32;
        const int ns4 = (pk == PK_UP && L == 1) ? 8 : 4, dil = gg == 0 ? 1 : (gg == 1 ? 4 : 16);
        pg8::Unit u;
        for (int i = 0; i < 8 && S.next(i, u); ++i) if (t < 256) {
            int tok;
            if (pk == PK_UP) tok = u.pm * 256 + t;
            else if (pk == PK_G1) tok = (u.pm >> 3) * 2048 + 64 * (t & 31) + (u.pm & 7) * 8 + (t >> 5);
            else tok = (u.pm >> 3) * 2048 + epi::tokmap((u.pm * 256 + t) & 2047, dil);
            rl[i * 256 + t] = rstd_tok(ssq, tok, ns4);
        }
    }
    __device__ __forceinline__ void operator()(epi::AccRef acc, const pg8::Unit& u, int ui, int wr, int wc, int fr, int fq) const {
        KArgs ka = (KArgs)__builtin_amdgcn_kernarg_segment_ptr(); asm volatile("" : "+s"(ka));
        unsigned char* ws = ka->ws; float* ssb = (float*)(ws + WS_SSP); bf16_t* xb = (bf16_t*)(ws + WS_XB);
        const int dil = gg == 0 ? 1 : (gg == 1 ? 4 : 16);
        switch (pk) {
        case PK_G1: { epi::FnetStore E{(bf16_t*)(ws + WS_GT), ssb + (size_t)(2 * L) * MTOK * 32, 4, rl}; E(acc, u, ui, wr, wc, fr, fq); } break;
        case PK_DOWN: { epi::Resid E{L == 3 ? ka->out : nullptr, xb, L < 3 ? ssb + (size_t)(2 * L + 2) * MTOK * 32 : nullptr, 0}; E(acc, u, ui, wr, wc, fr, fq); } break;
        case PK_GLU: { epi::Resid E{nullptr, xb, ssb + (size_t)3 * MTOK * 32, 1}; E(acc, u, ui, wr, wc, fr, fq); } break;
        case PK_WO: { epi::Resid E{nullptr, xb, ssb + (size_t)5 * MTOK * 32, 0}; E(acc, u, ui, wr, wc, fr, fq); } break;
        case PK_FC: { epi::Resid E{nullptr, xb, ssb + (size_t)(2 * L + 1) * MTOK * 32, 0}; E(acc, u, ui, wr, wc, fr, fq); } break;
        case PK_UP: {
            if (ui == 0 && L != 1) {
                unsigned* ctl = (unsigned*)(ws + WS_CTL);
                if (threadIdx.x == 0) XB_SPIN(xb_ld(ctl + CW_ADONE + 64 * L) < 256u, ctl + CW_BAR);
                __syncthreads();
            }
            epi::SwiGlu E{(bf16_t*)(ws + WS_HD), ssb + (size_t)(2 * L + 1) * MTOK * 32, L == 1 ? 8 : 4, rl}; E(acc, u, ui, wr, wc, fr, fq); } break;
        case PK_QK: { epi::QkNorm E{(bf16_t*)(ws + WS_QC), (bf16_t*)(ws + WS_KC), (bf16_t*)(ws + WS_VC), ssb + (size_t)4 * MTOK * 32, 4, ka->in[14] + gg * 64, ka->in[15] + gg * 64, dil, 0.125f * LOG2E, rl}; E(acc, u, ui, wr, wc, fr, fq); } break;
        case PK_S5A: { epi::StoreS5Lds E{(LAS unsigned char*)rl - (LDSCTL_OFF + 4096)}; E(acc, u, ui, wr, wc, fr, fq); } break;
        default: { epi::S5Out E{(bf16_t*)(ws + WS_YBUF), (const bf16_t*)(ws + WS_UCAT), ka->in[11]}; E(acc, u, ui, wr, wc, fr, fq); } break;
        }
    }
};

__global__ void __launch_bounds__(NTHREADS, 2) hybrid_fwd(Args args) {
    extern __shared__ __attribute__((aligned(16))) unsigned char lds_raw[];
    Frame F;
    F.lds = (LAS unsigned char*)lds_raw;
    F.tid = threadIdx.x; F.lane = F.tid & 63; F.wave = __builtin_amdgcn_readfirstlane(F.tid >> 6);
    F.G = gridDim.x; { const int bx = blockIdx.x; F.vcu = (F.G % 8 == 0) ? (bx % 8) * (F.G / 8) + bx / 8 : bx; }
    F.ka = (KArgs)__builtin_amdgcn_kernarg_segment_ptr();
    volatile LAS unsigned* MISC = (volatile LAS unsigned*)(F.lds + MISC_OFF);
    for (int u = F.tid; u < (LDS_BYTES - LDSCTL_OFF) / 4; u += NTHREADS) ((LAS unsigned*)(F.lds + LDSCTL_OFF))[u] = 0u;
    __syncthreads();
    unsigned* barw = (unsigned*)(F.ws() + WS_CTL) + CW_BAR;
    XcdBarrier bar; bar.bar = barw; bar.x = 0; bar.st = nullptr;
    const bool multi = (args.ph_hi - args.ph_lo) > 1;
    if (multi) bar = xcd_barrier_post(barw, MISC + 8);
    unsigned* gmap = (unsigned*)(F.ws() + WS_CTL) + CW_GMAP;
    if (multi && threadIdx.x == 0) (void)__hip_atomic_fetch_or(&gmap[64 * (blockIdx.x & 7)], 1u << bar.x, __ATOMIC_RELAXED, __HIP_MEMORY_SCOPE_AGENT);
    int grp_local = -1;

    int prev_kind = -1, prev_nobar = 0;
    for (int ph = args.ph_lo; ph < args.ph_hi; ++ph) {
        const PhaseDesc pd = phase_desc(ph);
        const int L = pd.layer;
        { KArgs k = (KArgs)__builtin_amdgcn_kernarg_segment_ptr(); asm volatile("" : "+s"(k)); F.ka = k; int t_ = threadIdx.x; asm volatile("" : "+v"(t_)); F.tid = t_; F.lane = t_ & 63; F.wave = __builtin_amdgcn_readfirstlane(t_ >> 6); }
        unsigned char* ws = F.ws();
        float* ssb = (float*)(ws + WS_SSP);
        bf16_t* xb = (bf16_t*)(ws + WS_XB);
        pg8::Geo g{}; EpiAny e; e.pk = pd.kind; e.L = L; e.gg = pd.g; bool is_gemm = true;
        g.rsA = g.rsB = DM * 2; g.hsA = g.hsB = 128 * DM * 2; g.tsA = g.tsB = (size_t)256 * DM * 2; g.K = DM;
        e.rl = (LAS float*)(F.lds + LDSCTL_OFF + 4096);
        switch (pd.kind) {
        case PK_G1:
            g.A = (const char*)xb; g.B = (const char*)(ws + WS_FH) + (size_t)(L == 0 ? 0 : 1) * 1024 * 256 * 2; g.nM = 64; g.nN = 4; g.modeA = 2; g.hsA = 4 * 2048;
            g.K = 256; g.kwA = 512; g.rsB = 512; g.hsB = 128 * 512; g.tsB = (size_t)256 * 512;
            break;
        case PK_FC:
            g.A = (const char*)(ws + WS_RF); g.B = (const char*)(ws + WS_WOUT) + (size_t)(L == 0 ? 0 : 1) * DM * DM * 2; g.nM = 64; g.nN = 4;
            break;
        case PK_UP:
            g.A = (const char*)xb; g.B = (const char*)(ws + WS_WUP) + (size_t)L * 2 * DFF * DM * 2; g.nM = 64; g.nN = 22;
            break;
        case PK_DOWN:
            g.A = (const char*)(ws + WS_HD); g.B = (const char*)(ws + WS_WDN) + (size_t)L * DM * DFF * 2; g.K = DFF; g.nM = 64; g.nN = 4;
            g.rsA = g.rsB = DFF * 2; g.hsA = g.hsB = 128 * DFF * 2; g.tsA = g.tsB = (size_t)256 * DFF * 2;
            break;
        case PK_S5A:
            g.A = (const char*)(ws + WS_UCAT); g.B = (const char*)(ws + WS_BCAT); g.K = 256; g.nM = 256; g.nN = 1;
            g.rsA = 1024; g.hsA = 128 * 1024; g.tsA = (size_t)256 * 1024; g.rsB = 512; g.hsB = 128 * 512; g.tsB = (size_t)256 * 512; g.bsel = 1;
            break;
        case PK_S5C:
            g.A = (const char*)(ws + WS_UCAT); g.B = (const char*)(ws + WS_ACAT); g.K = 512; g.nM = 256; g.nN = 1;
            g.rsA = 1024; g.hsA = 128 * 1024; g.tsA = (size_t)256 * 1024; g.rsB = 1024; g.hsB = 128 * 1024; g.tsB = (size_t)256 * 1024; g.bsel = 1;
            break;
        case PK_GLU:
            g.A = (const char*)(ws + WS_YBUF); g.B = (const char*)(ws + WS_WGLU); g.nM = 64; g.nN = 8;
            break;
        case PK_QK: {
            const int dil = pd.g == 0 ? 1 : (pd.g == 1 ? 4 : 16);
            g.A = (const char*)xb; g.B = (const char*)(ws + WS_WQK) + (size_t)pd.g * 3072 * DM * 2; g.nM = 64; g.nN = 12;
            g.modeA = 1; g.dil = dil; g.rsA = dil * 2048; g.hsA = dil == 16 ? 2048 : 128 * dil * 2048;
        } break;
        case PK_WO:
            g.A = (const char*)(ws + WS_OACC); g.B = (const char*)(ws + WS_WO); g.nM = 64; g.nN = 4;
            break;
        default: is_gemm = false; break;
        }
        pg8::StaticOrder S; S.init(g.nM, g.nN, F.G, (int)blockIdx.x);
        if (prev_nobar == 2) { asm volatile("s_waitcnt vmcnt(0)" ::: "memory"); __syncthreads(); }
        else if (prev_kind >= 0) {
            bool loc = prev_kind == PK_G1 || prev_kind == PK_G2 || prev_kind == PK_FC || prev_kind == PK_UP || prev_kind == PK_GLU || prev_kind == PK_QK || prev_kind == PK_ATT || prev_kind == PK_WO;
            if (loc && grp_local < 0) {
                unsigned ok = 1u;
#pragma unroll
                for (int j = 0; j < 8; ++j) { const unsigned m = xb_ld(&gmap[64 * j]); ok &= (m != 0u && (m & (m - 1u)) == 0u) ? 1u : 0u; }
                grp_local = __builtin_amdgcn_readfirstlane((int)ok);
            }
            const char* pf = nullptr; pg8::Unit u0;
            if (is_gemm && prev_kind != PK_PREP && prev_kind != PK_DOWN && S.next(0, u0)) pf = g.B + g.offB(u0);
            xcd_barrier(bar, loc && grp_local > 0, pf, g.rsB);
        }
        prev_kind = pd.kind; prev_nobar = pd.nobar;
        if (multi && threadIdx.x == 0 && (pd.kind == PK_FC || pd.kind == PK_WO)) (void)xb_add((unsigned*)(F.ws() + WS_CTL) + CW_ADONE + 64 * L, 1u);
        if (pd.kind == PK_S5A) { pg8::Unit u0; if (S.next(0, u0)) s5_gather(F, u0.pm); asm volatile("s_waitcnt vmcnt(0)" ::: "memory"); __syncthreads(); }
        if (is_gemm) {
            const bool cfirst = pd.kind == PK_UP && (((int)blockIdx.x >> 3) & 1) != 0;
            if (cfirst) { prep_background(F, L); asm volatile("s_waitcnt vmcnt(0) lgkmcnt(0)" ::: "memory"); __syncthreads(); }
            pg8::gemm_phase(F.lds, g, S, e);
            if (pd.kind == PK_UP && !cfirst) prep_background(F, L);
        }
#ifndef NO_PREP
        else if (pd.kind == PK_PREP) phase_prep(F);
#endif
#ifndef NO_S5X
        else if (pd.kind == PK_S5SCAN) { pg8::StaticOrder S; S.init(256, 1, F.G, (int)blockIdx.x); pg8::Unit u; if (S.next(0, u)) phase_s5scan(F, u.pm); }
#endif
#ifndef NO_ATTN
        else if (pd.kind == PK_ATT) phase_attn(F, pd.g);
#endif
        else if (pd.kind == PK_G2) phase_fdft(F);
        else {}
    }
}

extern "C" void kernel_launch(void* const* d_in, const int* in_sizes, int n_in, void* d_out, int out_size, void* d_ws, size_t ws_size, hipStream_t stream) {
    static int grid = 0;
    if (grid == 0) {
        if (n_in != 20 || in_sizes[0] != MTOK * DM || out_size != MTOK * DM || ws_size < WS_END) { fprintf(stderr, "kernel_launch: unexpected shapes / workspace (n_in %d, ws %zu)\n", n_in, ws_size); grid = -1; return; }
        int dev = 0, cus = 0, per_cu = 0;
        if (hipGetDevice(&dev) != hipSuccess || hipDeviceGetAttribute(&cus, hipDeviceAttributeMultiprocessorCount, dev) != hipSuccess) { grid = -1; return; }
        if (hipFuncSetAttribute((const void*)hybrid_fwd, hipFuncAttributeMaxDynamicSharedMemorySize, LDS_BYTES) != hipSuccess) { fprintf(stderr, "kernel_launch: hipFuncSetAttribute failed\n"); grid = -1; return; }
        if (hipOccupancyMaxActiveBlocksPerMultiprocessor(&per_cu, (const void*)hybrid_fwd, NTHREADS, LDS_BYTES) != hipSuccess || per_cu < 1) { fprintf(stderr, "kernel_launch: occupancy query reports %d\n", per_cu); }
        (void)hipGetLastError();
        if (cus < 256) { fprintf(stderr, "kernel_launch: built for 256 CUs with one resident workgroup each (got %d CUs); nothing launched\n", cus); grid = -1; return; }
        grid = 256;
    }
    if (grid < 0) return;
    (void)hipMemsetAsync((char*)d_ws + WS_CTL, 0, CTL_ZERO_BYTES, stream);
    Args a{};
    for (int i = 0; i < 20; ++i) a.in[i] = (const float*)d_in[i];
    a.out = (float*)d_out; a.ws = (unsigned char*)d_ws;
#if MK_ONE_LAUNCH
    a.ph_lo = 0; a.ph_hi = NPHASES;
    hipLaunchKernelGGL(hybrid_fwd, dim3(grid), dim3(NTHREADS), LDS_BYTES, stream, a);
#else
    for (int p = 0; p < NPHASES; ++p) { a.ph_lo = p; a.ph_hi = p + 1; hipLaunchKernelGGL(hybrid_fwd, dim3(grid), dim3(NTHREADS), LDS_BYTES, stream, a); }
#endif
}
```
